# Optimizing an MI355X kernel written in HIP

```python
import jax, jax.numpy as jnp
from jax import lax
import numpy as np

D_MODEL = 1024
BATCH = 2
SEQ = 8192
DEPTH = 1

MLA_HEADS = 8
MLA_NOPE = 128
MLA_ROPE = 64
MLA_V = 128
Q_LORA = 384
KV_LORA = 256
MOBA_HEADS = 8
MOBA_HD = 128
MOBA_BLOCK = 256
MOBA_TOPK = 3
MOBA_QCHUNK = 32
Q_BLOCK = 128
D_FF = 2816
CONV_W = 3

ROPE_THETA = 10000.0
EPS = 1e-6
NEG = -1e30
N_BRANCH = 2

OFF_QLAT = 0
OFF_KVLAT = OFF_QLAT + Q_LORA
OFF_KPE = OFF_KVLAT + KV_LORA
OFF_MOBA = OFF_KPE + MLA_ROPE
OFF_GATE = OFF_MOBA + 3 * MOBA_HEADS * MOBA_HD
IN_COLS = OFF_GATE + N_BRANCH * D_MODEL

kernel_name = 'hybrid_mla_moba_convffn_block'

F32 = jnp.float32


def rmsnorm(x, g):
    xf = x.astype(F32)
    y = xf * lax.rsqrt(jnp.mean(xf * xf, axis=-1, keepdims=True) + EPS)
    return (y * g.astype(F32)).astype(x.dtype)


def rope(x, pos):
    d = x.shape[-1]
    inv = ROPE_THETA ** (-jnp.arange(0, d, 2, dtype=F32) / d)
    ang = pos.astype(F32)[:, None] * inv[None, :]
    cos, sin = jnp.cos(ang), jnp.sin(ang)
    x1, x2 = jnp.split(x.astype(F32), 2, axis=-1)
    out = jnp.concatenate([x1 * cos - x2 * sin, x1 * sin + x2 * cos], axis=-1)
    return out.astype(x.dtype)


def causal_attention_blocks(q, k, v, scale):
    B, H, S, Dk = q.shape
    nq = S // Q_BLOCK
    qb = jnp.moveaxis(q.reshape(B, H, nq, Q_BLOCK, Dk), 2, 0)
    kpos = jnp.arange(S)

    def blk_fn(args):
        i, qi = args
        qpos = i * Q_BLOCK + jnp.arange(Q_BLOCK)
        s = jnp.einsum('bhqd,bhkd->bhqk', qi, k).astype(F32) * scale
        s = jnp.where(kpos[None, :] <= qpos[:, None], s, NEG)
        p = jax.nn.softmax(s, axis=-1).astype(v.dtype)
        return jnp.einsum('bhqk,bhkd->bhqd', p, v)

    out = lax.map(blk_fn, (jnp.arange(nq), qb))
    return jnp.moveaxis(out, 0, 2).reshape(B, H, S, v.shape[-1])


def moba_attention(q, k, v):
    B, H, S, D = q.shape
    nb = -(-S // MOBA_BLOCK)
    Sp = nb * MOBA_BLOCK
    pad = ((0, 0), (0, 0), (0, Sp - S), (0, 0))
    q, k, v = jnp.pad(q, pad), jnp.pad(k, pad), jnp.pad(v, pad)
    kb = k.reshape(B, H, nb, MOBA_BLOCK, D)
    vb = v.reshape(B, H, nb, MOBA_BLOCK, D)
    kmean = jnp.mean(kb.astype(F32), axis=3)
    gate = jnp.einsum('bhsd,bhnd->bhsn', q.astype(F32), kmean)
    q_blk = jnp.arange(Sp) // MOBA_BLOCK
    past = jnp.arange(nb)[None, :] < q_blk[:, None]
    gate = jnp.where(past, gate, -jnp.inf)
    k_sel = min(MOBA_TOPK, nb)
    top_s, top_idx = lax.top_k(gate, k_sel)
    top_ok = jnp.isfinite(top_s)

    nc = Sp // MOBA_QCHUNK

    def to_chunks(t):
        return jnp.moveaxis(t.reshape((B, H, nc, MOBA_QCHUNK) + t.shape[3:]), 2, 0)

    scale = D ** -0.5
    gather = jax.vmap(jax.vmap(lambda t, ix: t[ix]))

    def chunk_fn(args):
        c, qc, ic, okc = args
        qpos = c * MOBA_QCHUNK + jnp.arange(MOBA_QCHUNK)
        blk = (c * MOBA_QCHUNK) // MOBA_BLOCK
        ks = gather(kb, ic)
        vs = gather(vb, ic)
        ko = lax.dynamic_index_in_dim(kb, blk, axis=2, keepdims=False)
        vo = lax.dynamic_index_in_dim(vb, blk, axis=2, keepdims=False)
        s_sel = jnp.einsum('bhcd,bhckjd->bhckj', qc, ks).astype(F32) * scale
        s_sel = jnp.where(okc[..., None], s_sel, NEG)
        s_own = jnp.einsum('bhcd,bhjd->bhcj', qc, ko).astype(F32) * scale
        kpos = blk * MOBA_BLOCK + jnp.arange(MOBA_BLOCK)
        s_own = jnp.where(kpos[None, :] <= qpos[:, None], s_own, NEG)
        s = jnp.concatenate([s_sel.reshape(B, H, MOBA_QCHUNK, k_sel * MOBA_BLOCK), s_own], axis=-1)
        p = jax.nn.softmax(s, axis=-1).astype(v.dtype)
        p_sel = p[..., :k_sel * MOBA_BLOCK].reshape(B, H, MOBA_QCHUNK, k_sel, MOBA_BLOCK)
        p_own = p[..., k_sel * MOBA_BLOCK:]
        return (jnp.einsum('bhckj,bhckjd->bhcd', p_sel, vs)
                + jnp.einsum('bhcj,bhjd->bhcd', p_own, vo))

    out = lax.map(chunk_fn, (jnp.arange(nc), to_chunks(q), to_chunks(top_idx), to_chunks(top_ok)))
    return jnp.moveaxis(out, 0, 2).reshape(B, H, Sp, D)[:, :, :S]


def causal_dwconv(u, w, b):
    S = u.shape[1]
    up = jnp.pad(u, ((0, 0), (CONV_W - 1, 0), (0, 0)))
    y = b
    for j in range(CONV_W):
        y = y + w[j] * up[:, j:j + S]
    return y


def setup_inputs(seed: int = 0) -> dict:
    key = jax.random.key(seed)
    ks = jax.random.split(key, 20)
    L = DEPTH

    def w(k, shape, fan_in):
        return jax.random.normal(k, shape, F32) * fan_in ** -0.5

    def gain(k, shape):
        return 1.0 + 0.02 * jax.random.normal(k, shape, F32)

    return {
        'x': jax.random.normal(ks[0], (BATCH, SEQ, D_MODEL), F32),
        'attn_norm': gain(ks[1], (L, D_MODEL)),
        'w_in': w(ks[2], (L, D_MODEL, IN_COLS), D_MODEL),
        'b_gate': 0.02 * jax.random.normal(ks[3], (L, N_BRANCH * D_MODEL), F32),
        'q_norm': gain(ks[4], (L, Q_LORA)),
        'w_uq': w(ks[5], (L, Q_LORA, MLA_HEADS * (MLA_NOPE + MLA_ROPE)), Q_LORA),
        'kv_norm': gain(ks[6], (L, KV_LORA)),
        'w_ukv': w(ks[7], (L, KV_LORA, MLA_HEADS * (MLA_NOPE + MLA_V)), KV_LORA),
        'w_o_mla': w(ks[8], (L, MLA_HEADS * MLA_V, D_MODEL), MLA_HEADS * MLA_V),
        'w_o_moba': w(ks[9], (L, MOBA_HEADS * MOBA_HD, D_MODEL), MOBA_HEADS * MOBA_HD),
        'w_out': w(ks[10], (L, D_MODEL, D_MODEL), D_MODEL),
        'ffn_norm': gain(ks[11], (L, D_MODEL)),
        'w_up': w(ks[12], (L, D_MODEL, 2 * D_FF), D_MODEL),
        'conv_w': w(ks[13], (L, CONV_W, 2 * D_FF), CONV_W),
        'conv_b': 0.02 * jax.random.normal(ks[14], (L, 2 * D_FF), F32),
        'w_down': w(ks[15], (L, D_FF, D_MODEL), D_FF),
        'final_norm': gain(ks[16], (D_MODEL,)),
    }


def reference(x, attn_norm, w_in, b_gate, q_norm, w_uq, kv_norm, w_ukv, w_o_mla, w_o_moba,
              w_out, ffn_norm, w_up, conv_w, conv_b, w_down, final_norm):
    B, S, _ = x.shape
    pos = jnp.arange(S)
    for l in range(DEPTH):
        h = rmsnorm(x, attn_norm[l])
        proj = h @ w_in[l]
        q_lat = proj[..., OFF_QLAT:OFF_KVLAT]
        kv_lat = proj[..., OFF_KVLAT:OFF_KPE]
        k_pe = proj[..., OFF_KPE:OFF_MOBA]
        qkv_b = proj[..., OFF_MOBA:OFF_GATE]
        gates = jax.nn.sigmoid(proj[..., OFF_GATE:] + b_gate[l])
        g_a, g_b = gates[..., :D_MODEL], gates[..., D_MODEL:]

        q = (rmsnorm(q_lat, q_norm[l]) @ w_uq[l]).reshape(B, S, MLA_HEADS, MLA_NOPE + MLA_ROPE)
        q = q.transpose(0, 2, 1, 3)
        kv = (rmsnorm(kv_lat, kv_norm[l]) @ w_ukv[l]).reshape(B, S, MLA_HEADS, MLA_NOPE + MLA_V)
        kv = kv.transpose(0, 2, 1, 3)
        q_a = jnp.concatenate([q[..., :MLA_NOPE], rope(q[..., MLA_NOPE:], pos)], axis=-1)
        k_rot = jnp.broadcast_to(rope(k_pe[:, None], pos), (B, MLA_HEADS, S, MLA_ROPE))
        k_a = jnp.concatenate([kv[..., :MLA_NOPE], k_rot], axis=-1)
        v_a = kv[..., MLA_NOPE:]
        y_a = causal_attention_blocks(q_a, k_a, v_a, (MLA_NOPE + MLA_ROPE) ** -0.5)
        y_a = y_a.transpose(0, 2, 1, 3).reshape(B, S, MLA_HEADS * MLA_V) @ w_o_mla[l]

        qkv = qkv_b.reshape(B, S, 3, MOBA_HEADS, MOBA_HD).transpose(2, 0, 3, 1, 4)
        y_b = moba_attention(rope(qkv[0], pos), rope(qkv[1], pos), qkv[2])
        y_b = y_b.transpose(0, 2, 1, 3).reshape(B, S, MOBA_HEADS * MOBA_HD) @ w_o_moba[l]

        x = x + (g_a * y_a + g_b * y_b) @ w_out[l]

        h = rmsnorm(x, ffn_norm[l])
        u = causal_dwconv(h @ w_up[l], conv_w[l], conv_b[l])
        x = x + (jax.nn.silu(u[..., :D_FF]) * u[..., D_FF:]) @ w_down[l]
    return rmsnorm(x, final_norm)
```

```cpp
#include <hip/hip_runtime.h>
#include <cstdio>
#include <cstdint>

#ifndef MK_N_LAUNCHES
#define MK_N_LAUNCHES 1
#endif

#define GAS __attribute__((address_space(1)))
#define LAS __attribute__((address_space(3)))
typedef unsigned short bf16_t;
typedef short bf16x8 __attribute__((ext_vector_type(8)));
typedef short s16x4 __attribute__((ext_vector_type(4)));
typedef float f32x4 __attribute__((ext_vector_type(4)));
typedef float f32x2 __attribute__((ext_vector_type(2)));
typedef float f32x16 __attribute__((ext_vector_type(16)));
typedef unsigned u32x4 __attribute__((ext_vector_type(4)));
typedef unsigned u32x2 __attribute__((ext_vector_type(2)));

constexpr int DM = 1024, BATCH = 2, SEQ = 8192, M = BATCH * SEQ;
constexpr int QL = 384, KVL = 256, KPE = 64;
constexpr int NLAT = 768;
constexpr int NMOBA = 3072, NGATE = 2048;
constexpr int NIN = NLAT + NMOBA + NGATE;
constexpr int NQ = 1536, NKV = 2048;
constexpr int DFF = 2816, NUP = 2 * DFF;
constexpr int NH = 8;
constexpr float EPS = 1e-6f;
constexpr int NWAVES = 8;

constexpr size_t MiB = 1u << 20;
constexpr size_t WS_CTL = 0, CTL_ZERO_BYTES = 1 * MiB;
constexpr size_t WS_WIN = 1 * MiB;
constexpr size_t WS_WUQ = WS_WIN + (size_t)NIN * DM * 2;
constexpr size_t WS_WUKV = WS_WUQ + (size_t)NQ * QL * 2;
constexpr size_t WS_WOA = WS_WUKV + (size_t)NKV * KVL * 2;
constexpr size_t WS_WOB = WS_WOA + (size_t)DM * DM * 2;
constexpr size_t WS_WOUT = WS_WOB + (size_t)DM * DM * 2;
constexpr size_t WS_WUP = WS_WOUT + (size_t)DM * DM * 2;
constexpr size_t WS_WDN = WS_WUP + (size_t)NUP * DM * 2;
constexpr size_t WS_CSB = WS_WDN + (size_t)DM * DFF * 2;
constexpr size_t WS_CSA = WS_CSB + (size_t)SEQ * 64 * 4 * 2;
constexpr size_t WS_KM = WS_CSA + (size_t)SEQ * 32 * 4 * 2;
constexpr size_t WS_FIXED_END = WS_KM + (size_t)16 * 32 * 128 * 2;
constexpr size_t A0 = 44 * MiB;
static_assert(WS_FIXED_END <= A0, "fixed region");
constexpr size_t WS_LAT = A0;
constexpr size_t WS_MQKV = A0 + 24 * MiB;
constexpr size_t WS_YB = A0 + 120 * MiB;
constexpr size_t WS_XN = A0 + 152 * MiB;
constexpr size_t WS_Q = A0 + 152 * MiB;
constexpr size_t WS_KV = A0 + 24 * MiB;
constexpr size_t WS_YA = A0 + 88 * MiB;
constexpr size_t WS_T = A0 + 24 * MiB;
constexpr size_t WS_Z = A0 + 152 * MiB;
constexpr size_t WS_XN2 = A0;
constexpr size_t WS_G = A0 + 32 * MiB;
constexpr size_t WS_ACT = A0 + 120 * MiB;
constexpr size_t WS_END = 256 * MiB;
static_assert(WS_ACT + (size_t)M * DFF * 2 <= WS_END && WS_Q + (size_t)M * NQ * 2 <= WS_END, "ws map");

constexpr int CW_TMO = 0, CW_CODE = 1, CW_BAR = 4096;

constexpr int RING_BYTES = 131072;
constexpr int LDSCTL_OFF = RING_BYTES, MISC_OFF = LDSCTL_OFF + 320;
constexpr int LDS_BYTES = 147456;

#define RLX_AGENT __ATOMIC_RELAXED, __HIP_MEMORY_SCOPE_AGENT
#define LDS_WAIT() asm volatile("s_waitcnt lgkmcnt(0)" ::: "memory")
#define VM_WAIT() asm volatile("s_waitcnt vmcnt(0)" ::: "memory")

__device__ __forceinline__ unsigned f2bf(float f) { unsigned u = __builtin_bit_cast(unsigned, f); return (u + 0x7fffu + ((u >> 16) & 1u)) >> 16; }
__device__ __forceinline__ unsigned pk2(float lo, float hi) { return f2bf(lo) | (f2bf(hi) << 16); }
__device__ __forceinline__ float bf_lo(unsigned w) { return __builtin_bit_cast(float, w << 16); }
__device__ __forceinline__ float bf_hi(unsigned w) { return __builtin_bit_cast(float, w & 0xffff0000u); }
__device__ __forceinline__ unsigned cvt_pk_bf16(float lo, float hi) { unsigned r; asm volatile("v_cvt_pk_bf16_f32 %0, %1, %2" : "=v"(r) : "v"(lo), "v"(hi)); return r; }
__device__ __forceinline__ float sigmoidf_(float x) { return __builtin_amdgcn_rcpf(1.f + __builtin_amdgcn_exp2f(-1.4426950408889634f * x)); }
__device__ __forceinline__ int tid_() { int t = threadIdx.x; asm volatile("" : "+v"(t)); return t; }
__device__ __forceinline__ float wave_sum(float v) {
#pragma unroll
    for (int o = 1; o < 64; o <<= 1) v += __shfl_xor(v, o);
    return v;
}

namespace pg8 {
constexpr int BM = 256, BK = 64, HALF = 128, HTB = HALF * BK * 2, STAGE_BYTES = 8 * HTB, NXCD = 8, WGM = 8;
__host__ __device__ __forceinline__ int lds_byte(int r, int c) { const int st = (r >> 4) * 2 + (c >> 5), rr = r & 15, cc = c & 31, ob = rr * 64 + cc * 2; return st * 1024 + (ob ^ (((ob >> 9) & 1) << 5)); }
__host__ __device__ __forceinline__ void stage_rc(int b, int& R, int& C) { const int st = b / 1024, sb = b % 1024, swz = sb ^ (((sb >> 9) & 1) << 5); R = (st >> 1) * 16 + swz / 64; C = (st & 1) * 32 + (swz % 64) / 2; }
__host__ __device__ __forceinline__ int perm32(int rho) { const int n = rho >> 4, i = rho & 15; return 8 * (i >> 2) + 4 * n + (i & 3); }

struct Unit { int pm, pn; };
struct Gemm { const bf16_t* A; const bf16_t* Bt; int M, N, K, lda; };

struct StaticOrder {
    int nM, nN, nwg, G, c;
    __host__ __device__ void init(int M_, int N_, int G_, int c_) { nM = M_ / BM; nN = N_ / BM; nwg = nM * nN; G = G_; c = c_; }
    __host__ __device__ bool next(int i, Unit& u) const {
        const long L = (long)i * G + c; if (L >= nwg) return false;
        int wgid = (int)L; { const int q = nwg / NXCD, r = nwg % NXCD, xcd = wgid % NXCD, off = wgid / NXCD; wgid = (xcd < r ? xcd * (q + 1) : r * (q + 1) + (xcd - r) * q) + off; }
        const int nig = WGM * nN, gid = wgid / nig, fm = gid * WGM, gsz = (nM - fm) < WGM ? (nM - fm) : WGM;
        u.pm = fm + ((wgid % nig) % gsz); u.pn = (wgid % nig) / gsz; return true;
    }
};

typedef f32x4 Acc[2][2][4][2];

struct EpiBf16R {
    static constexpr bool PERM = true;
    bf16_t* O0; int ld0; int t1; bf16_t* O1; int ld1; int t2; bf16_t* O2; int ld2;
    __device__ __forceinline__ void operator()(const Acc& acc, const Unit& u, int wr, int wc, int fr, int fq) const {
        bf16_t* base; int ldc, colt;
        if (u.pn < t1) { base = O0; ldc = ld0; colt = u.pn * BM; } else if (u.pn < t2) { base = O1; ldc = ld1; colt = (u.pn - t1) * BM; } else { base = O2; ldc = ld2; colt = (u.pn - t2) * BM; }
        const int row0 = u.pm * BM + wr * 64 + fr, col0 = colt + wc * 32 + 8 * fq;
#pragma unroll
        for (int ai = 0; ai < 2; ++ai)
#pragma unroll
            for (int m = 0; m < 4; ++m) { bf16_t* rowp = base + (size_t)(row0 + ai * HALF + m * 16) * ldc + col0;
#pragma unroll
                for (int bj = 0; bj < 2; ++bj) { const f32x4 v0 = acc[ai][bj][m][0], v1 = acc[ai][bj][m][1];
                    u32x4 w; w.x = cvt_pk_bf16(v0[0], v0[1]); w.y = cvt_pk_bf16(v0[2], v0[3]); w.z = cvt_pk_bf16(v1[0], v1[1]); w.w = cvt_pk_bf16(v1[2], v1[3]);
                    *(u32x4*)(rowp + bj * HALF) = w; } }
    }
};
struct EpiGateF32 {
    static constexpr bool PERM = false;
    float* T; const bf16_t* gate; const float* gbias; int gcol0;
    __device__ __forceinline__ void operator()(const Acc& acc, const Unit& u, int wr, int wc, int fr, int fq) const {
        const int row0 = u.pm * BM + wr * 64 + fr, col0 = u.pn * BM + wc * 32 + 4 * fq;
#pragma unroll
        for (int ai = 0; ai < 2; ++ai)
#pragma unroll
            for (int m = 0; m < 4; ++m) { const size_t row = (size_t)(row0 + ai * HALF + m * 16);
#pragma unroll
                for (int bj = 0; bj < 2; ++bj)
#pragma unroll
                    for (int n = 0; n < 2; ++n) { const int col = col0 + bj * HALF + n * 16;
                        const u32x2 gw = *(const u32x2*)(gate + row * NGATE + gcol0 + col); const f32x4 gb = *(const f32x4*)(gbias + gcol0 + col);
                        f32x4 o; o[0] = sigmoidf_(bf_lo(gw.x) + gb[0]) * acc[ai][bj][m][n][0]; o[1] = sigmoidf_(bf_hi(gw.x) + gb[1]) * acc[ai][bj][m][n][1];
                        o[2] = sigmoidf_(bf_lo(gw.y) + gb[2]) * acc[ai][bj][m][n][2]; o[3] = sigmoidf_(bf_hi(gw.y) + gb[3]) * acc[ai][bj][m][n][3];
                        *(f32x4*)(T + row * DM + col) = o; } }
    }
};
struct EpiGateAddBf16 {
    static constexpr bool PERM = true;
    bf16_t* Z; const float* T; const bf16_t* gate; const float* gbias; int gcol0;
    __device__ __forceinline__ void operator()(const Acc& acc, const Unit& u, int wr, int wc, int fr, int fq) const {
        const int row0 = u.pm * BM + wr * 64 + fr, col0 = u.pn * BM + wc * 32 + 8 * fq;
#pragma unroll
        for (int ai = 0; ai < 2; ++ai)
#pragma unroll
            for (int m = 0; m < 4; ++m) { const size_t row = (size_t)(row0 + ai * HALF + m * 16);
#pragma unroll
                for (int bj = 0; bj < 2; ++bj) { const int col = col0 + bj * HALF;
                    const u32x4 gw = *(const u32x4*)(gate + row * NGATE + gcol0 + col);
                    const f32x4 gb0 = *(const f32x4*)(gbias + gcol0 + col), gb1 = *(const f32x4*)(gbias + gcol0 + col + 4);
                    const f32x4 t0 = *(const f32x4*)(T + row * DM + col), t1 = *(const f32x4*)(T + row * DM + col + 4);
                    const f32x4 a0 = acc[ai][bj][m][0], a1 = acc[ai][bj][m][1];
                    float o[8];
                    o[0] = t0[0] + sigmoidf_(bf_lo(gw.x) + gb0[0]) * a0[0]; o[1] = t0[1] + sigmoidf_(bf_hi(gw.x) + gb0[1]) * a0[1];
                    o[2] = t0[2] + sigmoidf_(bf_lo(gw.y) + gb0[2]) * a0[2]; o[3] = t0[3] + sigmoidf_(bf_hi(gw.y) + gb0[3]) * a0[3];
                    o[4] = t1[0] + sigmoidf_(bf_lo(gw.z) + gb1[0]) * a1[0]; o[5] = t1[1] + sigmoidf_(bf_hi(gw.z) + gb1[1]) * a1[1];
                    o[6] = t1[2] + sigmoidf_(bf_lo(gw.w) + gb1[2]) * a1[2]; o[7] = t1[3] + sigmoidf_(bf_hi(gw.w) + gb1[3]) * a1[3];
                    u32x4 w; w.x = cvt_pk_bf16(o[0], o[1]); w.y = cvt_pk_bf16(o[2], o[3]); w.z = cvt_pk_bf16(o[4], o[5]); w.w = cvt_pk_bf16(o[6], o[7]);
                    *(u32x4*)(Z + row * DM + col) = w; } }
    }
};
struct EpiResF32 {
    static constexpr bool PERM = false;
    const float* base; float* out;
    __device__ __forceinline__ void operator()(const Acc& acc, const Unit& u, int wr, int wc, int fr, int fq) const {
        const int row0 = u.pm * BM + wr * 64 + fr, col0 = u.pn * BM + wc * 32 + 4 * fq;
#pragma unroll
        for (int ai = 0; ai < 2; ++ai)
#pragma unroll
            for (int m = 0; m < 4; ++m) { const size_t off = (size_t)(row0 + ai * HALF + m * 16) * DM + col0;
#pragma unroll
                for (int bj = 0; bj < 2; ++bj)
#pragma unroll
                    for (int n = 0; n < 2; ++n) { const f32x4 b = *(const f32x4*)(base + off + bj * HALF + n * 16); *(f32x4*)(out + off + bj * HALF + n * 16) = b + acc[ai][bj][m][n]; } }
    }
};

template <class Epi, class Sched, bool ALIGN_EPI = true>
__device__ __forceinline__ void gemm_phase(LAS unsigned char* lds, const Gemm g, const Sched& S, const Epi& E) {
    const int tid = tid_(), wid = __builtin_amdgcn_readfirstlane(tid >> 6), lane = tid & 63, wr = wid >> 2, wc = wid & 3, fr = lane & 15, fq = lane >> 4;
    const int K = g.K, nt = K / BK, lda = g.lda;
    unsigned voffA[2], voffB[2];
#pragma unroll
    for (int i = 0; i < 2; ++i) { int R, C; stage_rc(tid * 16 + i * 8192, R, C); const int Rb = Epi::PERM ? ((R & ~31) + perm32(R & 31)) : R;
        voffA[i] = (unsigned)(R * lda + C) * 2u; voffB[i] = (unsigned)(Rb * K + C) * 2u; }
    const size_t kstep = (size_t)(BK * 2);
    const size_t hstepA = (size_t)HALF * lda * 2, hstepB = (size_t)HALF * K * 2;
    const size_t tstepA = 2 * hstepA, tstepB = 2 * hstepB;
    const unsigned ldsw = (unsigned)wid * 1024u;
    const int aoff = lds_byte(wr * 64 + fr, fq * 8), boff = lds_byte(wc * 32 + fr, fq * 8);
#define PG8_SA(b, h) (((b) * 2 + (h)) * HTB)
#define PG8_SB(b, h) ((4 + (b) * 2 + (h)) * HTB)
#define PG8_STAGE(bufoff, gbase, voff) do { _Pragma("unroll") for (int _i = 0; _i < 2; ++_i) \
        __builtin_amdgcn_global_load_lds((const unsigned*)((const char*)(gbase) + (voff)[_i]), (LAS unsigned*)(lds + (bufoff) + ldsw + _i * 8192), 16, 0, 0); } while (0)
#define PG8_LDA(dst, b, h) do { _Pragma("unroll") for (int m = 0; m < 4; ++m) _Pragma("unroll") for (int k = 0; k < 2; ++k) dst[m][k] = *(const LAS bf16x8*)(lds + PG8_SA(b, h) + aoff + m * 2048 + k * 1024); } while (0)
#define PG8_LDB(dst, b, h) do { _Pragma("unroll") for (int n = 0; n < 2; ++n) _Pragma("unroll") for (int k = 0; k < 2; ++k) dst[n][k] = *(const LAS bf16x8*)(lds + PG8_SB(b, h) + boff + n * 2048 + k * 1024); } while (0)
#define PG8_MMA(ai, bj, At, Bt) do { __builtin_amdgcn_s_setprio(1); _Pragma("unroll") for (int m = 0; m < 4; ++m) _Pragma("unroll") for (int n = 0; n < 2; ++n) _Pragma("unroll") for (int k = 0; k < 2; ++k) \
        acc[ai][bj][m][n] = __builtin_amdgcn_mfma_f32_16x16x32_bf16(Bt[n][k], At[m][k], acc[ai][bj][m][n], 0, 0, 0); __builtin_amdgcn_s_setprio(0); } while (0)
#define PG8_WAIT_V(n) asm volatile("s_waitcnt vmcnt(" #n ")" ::: "memory")
#define PG8_WAIT_L(n) asm volatile("s_waitcnt lgkmcnt(" #n ")" ::: "memory")
#define PG8_BAR __builtin_amdgcn_s_barrier()
#define PG8_SCHED __builtin_amdgcn_sched_barrier(0)
    Unit cur, nxt; int ui = 0;
    if (!S.next(0, cur)) return;
    Acc acc;
#pragma unroll
    for (int a = 0; a < 2; ++a)
#pragma unroll
        for (int b = 0; b < 2; ++b)
#pragma unroll
            for (int m = 0; m < 4; ++m)
#pragma unroll
                for (int n = 0; n < 2; ++n) acc[a][b][m][n] = (f32x4){0.f, 0.f, 0.f, 0.f};
    bf16x8 At[4][2], B0[2][2], B1[2][2];
    const char* cA = (const char*)g.A + (size_t)cur.pm * tstepA; const char* cB = (const char*)g.Bt + (size_t)cur.pn * tstepB;
    PG8_STAGE(PG8_SB(0, 0), cB, voffB); PG8_STAGE(PG8_SB(0, 1), cB + hstepB, voffB); PG8_STAGE(PG8_SA(0, 0), cA, voffA); PG8_STAGE(PG8_SA(0, 1), cA + hstepA, voffA);
    if (wr == 1) PG8_BAR;
    PG8_WAIT_V(2); PG8_BAR;
    PG8_STAGE(PG8_SB(1, 0), cB + kstep, voffB); PG8_STAGE(PG8_SA(1, 0), cA + kstep, voffA); PG8_STAGE(PG8_SB(1, 1), cB + hstepB + kstep, voffB);
    PG8_WAIT_V(6); PG8_BAR;
    for (;;) {
        const bool has_next = S.next(ui + 1, nxt);
        const char* nA = has_next ? (const char*)g.A + (size_t)nxt.pm * tstepA : cA; const char* nB = has_next ? (const char*)g.Bt + (size_t)nxt.pn * tstepB : cB;
        for (int t = 0; t < nt; t += 2) {
            const bool last = (t == nt - 2);
            const char* a1 = cA + (size_t)(t + 1) * kstep;
            const char* a2 = last ? nA : cA + (size_t)(t + 2) * kstep; const char* b2 = last ? nB : cB + (size_t)(t + 2) * kstep;
            const char* a3 = a2 + kstep; const char* b3 = b2 + kstep;
            PG8_LDB(B0, 0, 0); PG8_LDB(B1, 0, 1); PG8_SCHED; PG8_LDA(At, 0, 0); PG8_STAGE(PG8_SA(1, 1), a1 + hstepA, voffA);
            PG8_WAIT_V(8); PG8_WAIT_L(0); PG8_BAR; PG8_MMA(0, 0, At, B0); PG8_MMA(0, 1, At, B1); PG8_BAR; PG8_SCHED;
            PG8_LDA(At, 0, 1); PG8_STAGE(PG8_SB(0, 0), b2, voffB); PG8_STAGE(PG8_SB(0, 1), b2 + hstepB, voffB); PG8_STAGE(PG8_SA(0, 0), a2, voffA);
            PG8_WAIT_V(8); PG8_WAIT_L(0); PG8_BAR; PG8_MMA(1, 0, At, B0); PG8_MMA(1, 1, At, B1); PG8_BAR; PG8_SCHED;
            PG8_LDB(B0, 1, 0); PG8_LDB(B1, 1, 1); PG8_SCHED; PG8_LDA(At, 1, 0); PG8_STAGE(PG8_SA(0, 1), a2 + hstepA, voffA);
            PG8_WAIT_V(8); PG8_WAIT_L(0); PG8_BAR; PG8_MMA(0, 0, At, B0); PG8_MMA(0, 1, At, B1); PG8_BAR; PG8_SCHED;
            PG8_LDA(At, 1, 1); PG8_STAGE(PG8_SB(1, 0), b3, voffB); PG8_STAGE(PG8_SB(1, 1), b3 + hstepB, voffB); PG8_STAGE(PG8_SA(1, 0), a3, voffA);
            PG8_WAIT_V(8); PG8_WAIT_L(0); PG8_BAR; PG8_MMA(1, 0, At, B0); PG8_MMA(1, 1, At, B1); PG8_BAR; PG8_SCHED;
        }
        if constexpr (ALIGN_EPI) { if (wr == 0) PG8_BAR; }
        E(acc, cur, wr, wc, fr, fq);
        if (!has_next) break;
#pragma unroll
        for (int a = 0; a < 2; ++a)
#pragma unroll
            for (int b = 0; b < 2; ++b)
#pragma unroll
                for (int m = 0; m < 4; ++m)
#pragma unroll
                    for (int n = 0; n < 2; ++n) acc[a][b][m][n] = (f32x4){0.f, 0.f, 0.f, 0.f};
        cur = nxt; cA = nA; cB = nB; ++ui;
        if constexpr (ALIGN_EPI) { if (wr == 1) PG8_BAR; }
    }
    PG8_WAIT_V(0);
    if constexpr (!ALIGN_EPI) { if (wr == 0) PG8_BAR; }
    PG8_BAR;
#undef PG8_SA
#undef PG8_SB
#undef PG8_STAGE
#undef PG8_LDA
#undef PG8_LDB
#undef PG8_MMA
#undef PG8_WAIT_V
#undef PG8_WAIT_L
#undef PG8_BAR
#undef PG8_SCHED
}
}

namespace att {
constexpr int NW = 8, QBLK = 32, KVBLK = 64, QB = NW * QBLK;
constexpr int SHM_V = KVBLK * 128 * 2, SHM_K = KVBLK * 128 * 2, SHM_KR = KVBLK * 64 * 2;
constexpr int OFF_V = 0, OFF_K = 2 * SHM_V, OFF_KR = OFF_K + 2 * SHM_K, OFF_WS = OFF_KR + 2 * SHM_KR, LDS_BYTES = OFF_WS + NW * 64 * 4;
constexpr float THR = 8.f;
#define KSWZ(row, colB) ((row) * 256 + ((colB) ^ (((row) & 7) << 4)))
#define KRSWZ(row, colB) ((row) * 128 + ((colB) ^ (((row) & 7) << 4)))
#define SBAR() __builtin_amdgcn_sched_barrier(0)
__device__ __forceinline__ int v_st(int k, int c) { const int kk = (k & ~0xC) | ((k & 4) << 1) | ((k & 8) >> 1); return ((kk >> 3) * 4 + (c >> 5)) * 512 + ((kk & 7) * 32 + (c & 31)) * 2; }
__device__ __forceinline__ int v_rd_base(int lane) { return ((lane & 3) << 3) | (((lane >> 2) & 3) << 6) | (((lane >> 4) & 1) << 5) | (((lane >> 5) & 1) << 8); }
constexpr int v_rd_off(int d0, int ks, int half) { return d0 * 512 + ks * 4096 + half * 2048; }
__device__ __forceinline__ int crow(int r, int hi) { return (r & 3) + 8 * (r >> 2) + 4 * hi; }
__device__ __forceinline__ unsigned cvtpk(float lo, float hi) { unsigned r; asm volatile("v_cvt_pk_bf16_f32 %0, %1, %2" : "=v"(r) : "v"(lo), "v"(hi)); return r; }

__device__ __forceinline__ void mask_tile(f32x16& p0, f32x16& p1, int dq) {
    const float NEG = -__builtin_inff();
#pragma unroll
    for (int r = 0; r < 16; ++r) {
        const int c = (r & 3) + 8 * (r >> 2);
        if (dq - c < 0) p0[r] = NEG;
        if (dq - c - 32 < 0) p1[r] = NEG;
    }
}
template <int SCALE_NUM>
__device__ __forceinline__ void partialSM(f32x16& p0, f32x16& p1, float& m_reg, float& mn, float& alpha) {
    constexpr float SCALE = SCALE_NUM == 192 ? 0.07216878364870322f : 0.08838834764831845f;
    float pmax = p0[0];
#pragma unroll
    for (int r = 1; r < 16; ++r) pmax = fmaxf(pmax, p0[r]);
#pragma unroll
    for (int r = 0; r < 16; ++r) pmax = fmaxf(pmax, p1[r]);
    { auto rr = __builtin_amdgcn_permlane32_swap(__float_as_uint(pmax), __float_as_uint(pmax), false, false);
      pmax = fmaxf(__uint_as_float(rr[0]), __uint_as_float(rr[1])); }
    constexpr float C2 = 1.4426950408889634f * SCALE;
    if (__builtin_expect(__all((pmax - m_reg) * SCALE <= THR), 1)) { mn = m_reg; alpha = 1.f; }
    else { mn = fmaxf(m_reg, pmax); alpha = __builtin_amdgcn_exp2f((m_reg - mn) * C2); m_reg = mn; }
    const float mnL = -mn * C2;
#pragma unroll
    for (int r = 0; r < 16; ++r) p0[r] = fmaf(p0[r], C2, mnL);
#pragma unroll
    for (int r = 0; r < 16; ++r) p1[r] = fmaf(p1[r], C2, mnL);
#pragma unroll
    for (int r = 0; r < 16; ++r) p0[r] = __builtin_amdgcn_exp2f(p0[r]);
}
__device__ __forceinline__ void finishSM(f32x16& p0, f32x16& p1, float alpha, float& l_reg, bf16x8& pa0, bf16x8& pa1, bf16x8& pa2, bf16x8& pa3) {
#pragma unroll
    for (int r = 0; r < 16; ++r) p1[r] = __builtin_amdgcn_exp2f(p1[r]);
    float ps = 0;
#pragma unroll
    for (int r = 0; r < 16; ++r) ps += p0[r];
#pragma unroll
    for (int r = 0; r < 16; ++r) ps += p1[r];
    { auto rr = __builtin_amdgcn_permlane32_swap(__float_as_uint(ps), __float_as_uint(ps), false, false);
      ps = __uint_as_float(rr[0]) + __uint_as_float(rr[1]); }
    l_reg = l_reg * alpha + ps;
#define PK4(P, B_, OUT) do { unsigned a0 = cvtpk(P[B_+0], P[B_+1]), a1 = cvtpk(P[B_+2], P[B_+3]);                          \
        unsigned b0 = cvtpk(P[B_+4], P[B_+5]), b1 = cvtpk(P[B_+6], P[B_+7]);                                             \
        auto r0 = __builtin_amdgcn_permlane32_swap(a0, b0, false, false); auto r1 = __builtin_amdgcn_permlane32_swap(a1, b1, false, false); \
        u32x4 w = {r0[0], r1[0], r0[1], r1[1]}; OUT = *reinterpret_cast<bf16x8*>(&w); } while (0)
    PK4(p0, 0, pa0); PK4(p0, 8, pa1); PK4(p1, 0, pa2); PK4(p1, 8, pa3);
#undef PK4
}
template <int KB, bool ROPE>
__device__ __forceinline__ void qkt(f32x16& p0, f32x16& p1, const char* lds, int r32, int hi, const bf16x8* qr) {
    p0 = f32x16{}; p1 = f32x16{};
    const char* kb[4];
#pragma unroll
    for (int dd = 0; dd < 4; ++dd) kb[dd] = lds + OFF_K + KB * SHM_K + KSWZ(r32, (dd * 16 + hi * 8) * 2);
#pragma unroll
    for (int d0 = 0; d0 < 8; ++d0) { const char* a = kb[d0 & 3] + (d0 >> 2) * 128;
        bf16x8 b0 = *reinterpret_cast<const bf16x8*>(a);
        bf16x8 b1 = *reinterpret_cast<const bf16x8*>(a + 32 * 256);
        p0 = __builtin_amdgcn_mfma_f32_32x32x16_bf16(b0, qr[d0], p0, 0, 0, 0);
        p1 = __builtin_amdgcn_mfma_f32_32x32x16_bf16(b1, qr[d0], p1, 0, 0, 0); }
    if constexpr (ROPE) {
#pragma unroll
        for (int dd = 0; dd < 4; ++dd) { const char* a = lds + OFF_KR + KB * SHM_KR + KRSWZ(r32, (dd * 16 + hi * 8) * 2);
            bf16x8 b0 = *reinterpret_cast<const bf16x8*>(a);
            bf16x8 b1 = *reinterpret_cast<const bf16x8*>(a + 32 * 128);
            p0 = __builtin_amdgcn_mfma_f32_32x32x16_bf16(b0, qr[8 + dd], p0, 0, 0, 0);
            p1 = __builtin_amdgcn_mfma_f32_32x32x16_bf16(b1, qr[8 + dd], p1, 0, 0, 0); }
    }
}
template <int VB>
__device__ __forceinline__ void pv_tile(f32x16* o, int vb0, bf16x8 pa0, bf16x8 pa1, bf16x8 pa2, bf16x8 pa3) {
#define TRRD(dst, off) asm volatile("ds_read_b64_tr_b16 %0, %1 offset:%2" : "=&v"(dst) : "v"(vb0), "i"(off) : "memory")
#define PV_D0(d0) do { s16x4 l0, l1, l2, l3, h0, h1, h2, h3; constexpr int b_ = OFF_V + VB * SHM_V + v_rd_off(d0, 0, 0);  \
        TRRD(l0, b_); TRRD(h0, b_ + 2048); TRRD(l1, b_ + 4096); TRRD(h1, b_ + 6144); TRRD(l2, b_ + 8192); TRRD(h2, b_ + 10240); TRRD(l3, b_ + 12288); TRRD(h3, b_ + 14336); \
        asm volatile("s_waitcnt lgkmcnt(0)" ::: "memory"); SBAR();   \
        o[d0] = __builtin_amdgcn_mfma_f32_32x32x16_bf16(pa0, (bf16x8){l0[0], l0[1], l0[2], l0[3], h0[0], h0[1], h0[2], h0[3]}, o[d0], 0, 0, 0);   \
        o[d0] = __builtin_amdgcn_mfma_f32_32x32x16_bf16(pa1, (bf16x8){l1[0], l1[1], l1[2], l1[3], h1[0], h1[1], h1[2], h1[3]}, o[d0], 0, 0, 0);   \
        o[d0] = __builtin_amdgcn_mfma_f32_32x32x16_bf16(pa2, (bf16x8){l2[0], l2[1], l2[2], l2[3], h2[0], h2[1], h2[2], h2[3]}, o[d0], 0, 0, 0);   \
        o[d0] = __builtin_amdgcn_mfma_f32_32x32x16_bf16(pa3, (bf16x8){l3[0], l3[1], l3[2], l3[3], h3[0], h3[1], h3[2], h3[3]}, o[d0], 0, 0, 0); } while (0)
    PV_D0(0); PV_D0(1); PV_D0(2); PV_D0(3);
#undef PV_D0
#undef TRRD
}

struct Head {
    const bf16_t* Q; const bf16_t* K; const bf16_t* KR; const bf16_t* V; bf16_t* O;
    const float* cosT; const float* sinT;
    const bf16_t* KM;
};
struct Stage { bf16x8 k0, k1, v0, v1, kr; };

template <bool MOBA>
__device__ __forceinline__ void attn_block(const Head& T, int qb, char* lds) {
    constexpr bool ROPE = !MOBA;
    constexpr int QS = MOBA ? NMOBA : NQ, KS = MOBA ? NMOBA : NKV, VS = KS, KRS = NLAT, OS = DM;
    const int tid = tid_(), wid = __builtin_amdgcn_readfirstlane(tid >> 6), lane = tid & 63, r32 = lane & 31, hi = lane >> 5;
    const int NT = (qb + 1) * 4;
    const int P0 = qb * QB, qlo = P0 + wid * QBLK, qm = qlo + r32 - 4 * hi;
    float* ws = (float*)(lds + OFF_WS) + wid * 64; float* li_l = ws, * al_l = ws + 32;
    const int sr = tid >> 4, sc = (tid & 15) * 8, vst0 = v_st(sr, sc), vst1 = v_st(32 + sr, sc), kws = KSWZ(sr, sc * 2);
    const int rr_ = tid >> 3, rc_ = (tid & 7) * 8, krws = KRSWZ(rr_, rc_ * 2);
    const int vb0 = (int)(uintptr_t)lds + v_rd_base(lane);
    bf16x8 qr[ROPE ? 12 : 8];
    { const char* qbase = (const char*)T.Q + (size_t)(P0 + wid * QBLK) * QS * 2; const unsigned qoff = (unsigned)(r32 * QS + hi * 8) * 2u;
#pragma unroll
      for (int d0 = 0; d0 < (ROPE ? 12 : 8); ++d0) qr[d0] = *reinterpret_cast<const bf16x8*>(qbase + qoff + d0 * 32);
      if constexpr (ROPE) {
          const int pos = P0 + wid * QBLK + r32;
#pragma unroll
          for (int dd = 0; dd < 2; ++dd) {
              const f32x4 c0 = *(const f32x4*)(T.cosT + (size_t)pos * 32 + dd * 16 + hi * 8), c1 = *(const f32x4*)(T.cosT + (size_t)pos * 32 + dd * 16 + hi * 8 + 4);
              const f32x4 s0 = *(const f32x4*)(T.sinT + (size_t)pos * 32 + dd * 16 + hi * 8), s1 = *(const f32x4*)(T.sinT + (size_t)pos * 32 + dd * 16 + hi * 8 + 4);
              const u32x4 x1 = __builtin_bit_cast(u32x4, qr[8 + dd]), x2 = __builtin_bit_cast(u32x4, qr[10 + dd]);
              u32x4 y1, y2;
#pragma unroll
              for (int w = 0; w < 4; ++w) {
                  const float a_lo = bf_lo(x1[w]), a_hi = bf_hi(x1[w]), b_lo = bf_lo(x2[w]), b_hi = bf_hi(x2[w]);
                  const float cl = (w < 2 ? c0 : c1)[(2 * w) & 3], ch = (w < 2 ? c0 : c1)[(2 * w + 1) & 3];
                  const float sl = (w < 2 ? s0 : s1)[(2 * w) & 3], sh = (w < 2 ? s0 : s1)[(2 * w + 1) & 3];
                  y1[w] = pk2(a_lo * cl - b_lo * sl, a_hi * ch - b_hi * sh);
                  y2[w] = pk2(a_lo * sl + b_lo * cl, a_hi * sh + b_hi * ch);
              }
              qr[8 + dd] = __builtin_bit_cast(bf16x8, y1); qr[10 + dd] = __builtin_bit_cast(bf16x8, y2);
          }
      }
    }
    int sel0 = -1, sel1 = -1, sel2 = -1;
    if constexpr (MOBA) {
        f32x16 g = f32x16{};
        const unsigned kmoff = (unsigned)(r32 * 128 + hi * 8) * 2u;
#pragma unroll
        for (int d0 = 0; d0 < 8; ++d0) { const bf16x8 a = *reinterpret_cast<const bf16x8*>((const char*)T.KM + kmoff + d0 * 32); g = __builtin_amdgcn_mfma_f32_32x32x16_bf16(a, qr[d0], g, 0, 0, 0); }
        const float NEG = -__builtin_inff();
        float v0 = NEG, v1 = NEG, v2 = NEG;
#define INS3(x, bi) do { const float x_ = (x); const int b_ = (bi);                                                     \
            const bool g0 = (x_ > v0) || (x_ == v0 && x_ > NEG && b_ < sel0), g1 = (x_ > v1) || (x_ == v1 && x_ > NEG && b_ < sel1), g2 = (x_ > v2) || (x_ == v2 && x_ > NEG && b_ < sel2); \
            if (g0) { v2 = v1; sel2 = sel1; v1 = v0; sel1 = sel0; v0 = x_; sel0 = b_; }                                      \
            else if (g1) { v2 = v1; sel2 = sel1; v1 = x_; sel1 = b_; }                                                       \
            else if (g2) { v2 = x_; sel2 = b_; } } while (0)
#pragma unroll
        for (int r = 0; r < 16; ++r) { const int blk = crow(r, hi); const float x = blk < qb ? g[r] : NEG; INS3(x, blk); }
        const float pv0 = __shfl_xor(v0, 32), pv1 = __shfl_xor(v1, 32), pv2 = __shfl_xor(v2, 32);
        const int ps0 = __shfl_xor(sel0, 32), ps1 = __shfl_xor(sel1, 32), ps2 = __shfl_xor(sel2, 32);
        INS3(pv0, ps0); INS3(pv1, ps1); INS3(pv2, ps2);
#undef INS3
    }
    float m_reg = -1e30f, l_reg = 0; f32x16 o[4] = {};
    Stage S;
    const unsigned koff0 = (unsigned)(sr * KS + sc) * 2u, koff1 = (unsigned)((32 + sr) * KS + sc) * 2u, kroff = (unsigned)(rr_ * KRS + rc_) * 2u;
#define SLOAD(kp_) do { const char* kp__ = (const char*)T.K + (size_t)(kp_) * KS * 2; const char* vp__ = (const char*)T.V + (size_t)(kp_) * VS * 2;          \
                       S.v0 = *reinterpret_cast<const bf16x8*>(vp__ + koff0); S.v1 = *reinterpret_cast<const bf16x8*>(vp__ + koff1);   \
                       S.k0 = *reinterpret_cast<const bf16x8*>(kp__ + koff0); S.k1 = *reinterpret_cast<const bf16x8*>(kp__ + koff1);   \
                       if constexpr (ROPE) S.kr = *reinterpret_cast<const bf16x8*>((const char*)T.KR + (size_t)(kp_) * KRS * 2 + kroff); } while (0)
#define SWRITE(bf) do { *(bf16x8*)(lds + OFF_K + (bf) * SHM_K + kws) = S.k0; *(bf16x8*)(lds + OFF_K + (bf) * SHM_K + kws + 32 * 256) = S.k1;       \
                        *(bf16x8*)(lds + OFF_V + (bf) * SHM_V + vst0) = S.v0; *(bf16x8*)(lds + OFF_V + (bf) * SHM_V + vst1) = S.v1;                  \
                        if constexpr (ROPE) *(bf16x8*)(lds + OFF_KR + (bf) * SHM_KR + krws) = S.kr; } while (0)
#define RESC(a) do { if (__any((a) < 1.f)) { if (hi == 0) al_l[r32] = (a); asm volatile("s_waitcnt lgkmcnt(0)" ::: "memory");              \
                     _Pragma("unroll") for (int d_ = 0; d_ < 4; ++d_) _Pragma("unroll") for (int r = 0; r < 16; ++r) o[d_][r] *= al_l[crow(r, hi)]; } } while (0)
#define STEP(t, BF) do {                                                                                                     \
        const int kb_ = (t) * KVBLK; const bool more_ = (t) + 1 < NT;                                                        \
        if (more_) SLOAD(kb_ + KVBLK);                                                                                       \
        bool act_; bool keep_ = true;                                                                                        \
        if constexpr (MOBA) { const int j_ = (t) >> 2; if (j_ < qb) { keep_ = (j_ == sel0) || (j_ == sel1) || (j_ == sel2); act_ = __any(keep_); } else { act_ = kb_ <= qlo + QBLK - 1; } } \
        else { act_ = kb_ <= qlo + QBLK - 1; }                                                                               \
        if (act_) {                                                                                                          \
            f32x16 p0, p1; float mn, al; bf16x8 pa0, pa1, pa2, pa3;                                                          \
            SBAR(); qkt<BF, ROPE>(p0, p1, lds, r32, hi, qr); SBAR();                                                         \
            if (MOBA && ((t) >> 2) < qb) { if (!keep_) { const float NEG_ = -__builtin_inff(); _Pragma("unroll") for (int r = 0; r < 16; ++r) { p0[r] = NEG_; p1[r] = NEG_; } } } \
            else if (kb_ + KVBLK - 1 > qlo) mask_tile(p0, p1, qm - kb_);                                                     \
            partialSM<MOBA ? 128 : 192>(p0, p1, m_reg, mn, al);                                                              \
            RESC(al);                                                                                                        \
            finishSM(p0, p1, al, l_reg, pa0, pa1, pa2, pa3); SBAR();                                                         \
            pv_tile<BF>(o, vb0, pa0, pa1, pa2, pa3); SBAR();                                                                 \
        }                                                                                                                    \
        if (more_) { VM_WAIT(); SWRITE((BF) ^ 1); }                                                                          \
        __syncthreads(); } while (0)
    SLOAD(0); VM_WAIT(); SWRITE(0); __syncthreads();
    for (int t = 0; t < NT; t += 2) { STEP(t, 0); STEP(t + 1, 1); }
    if (hi == 0) li_l[r32] = l_reg; asm volatile("s_waitcnt lgkmcnt(0)" ::: "memory");
    float rli[16];
#pragma unroll
    for (int r = 0; r < 16; ++r) rli[r] = __builtin_amdgcn_rcpf(li_l[crow(r, hi)]);
    char* Ow = (char*)T.O + (size_t)(P0 + wid * QBLK) * OS * 2; const unsigned ooff = (unsigned)(4 * hi * OS + r32) * 2u;
#pragma unroll
    for (int r = 0; r < 16; ++r) { const int orow0 = (r & 3) + 8 * (r >> 2);
#pragma unroll
        for (int d0 = 0; d0 < 4; ++d0) { const float v = o[d0][r] * rli[r];
            const float vn = __shfl_xor(v, 1);
            if ((r32 & 1) == 0) *(unsigned*)(Ow + ooff + (orow0 * OS + d0 * 32) * 2) = cvtpk(v, vn); } }
    __syncthreads();
#undef SLOAD
#undef SWRITE
#undef RESC
#undef STEP
}
#undef KSWZ
#undef KRSWZ
#undef SBAR
}

typedef GAS unsigned gu32;
#define XB_TMO      128
#define XB_XCNT(j)  (256  + 64 * (j))
#define XB_XSUB(j)  (1280 + 64 * (j))
#define XB_XGEN(j)  (2304 + 64 * (j))
#define XB_TOP      3328
#define XB_TOPGEN   3392
#define XCD_BAR_WORDS 3456
#define XB_SPIN_CAP (1u << 18)
__device__ __forceinline__ unsigned xb_ld(unsigned* p)              { return __hip_atomic_load(p, __ATOMIC_RELAXED, __HIP_MEMORY_SCOPE_AGENT); }
__device__ __forceinline__ unsigned xb_add(unsigned* p, unsigned v) { return __hip_atomic_fetch_add(p, v, __ATOMIC_RELAXED, __HIP_MEMORY_SCOPE_AGENT); }
__device__ __forceinline__ unsigned xb_xcc_id() { return (unsigned)__builtin_amdgcn_s_getreg((3 << 11) | 20) & 0xFu; }
#define XB_SPIN(cond, bar) do { unsigned _sp = 0; while (cond) { __builtin_amdgcn_s_sleep(1); \
    if ((++_sp & 255u) == 0u) { if (xb_ld(&(bar)[XB_TMO])) break; if (_sp > XB_SPIN_CAP) { atomicAdd(&(bar)[XB_TMO], 1u); break; } } } } while (0)
struct XcdBarrier { unsigned* bar; unsigned x; volatile LAS unsigned* st; };
__device__ __forceinline__ XcdBarrier xcd_barrier_post(unsigned* bar, volatile LAS unsigned* st) {
    XcdBarrier b; b.bar = bar; b.x = xb_xcc_id(); b.st = st;
    if (threadIdx.x == 0) (void)xb_add(&bar[XB_XCNT(b.x)], 1u);
    return b;
}
__device__ __forceinline__ void xcd_barrier_complete(unsigned* bar, unsigned x, unsigned& nloc, unsigned& nx) {
    const unsigned G = gridDim.x * gridDim.y * gridDim.z;
    unsigned sum, cnt, mine, sp = 0u;
    for (;;) {
        sum = 0u; cnt = 0u; mine = 0u;
#pragma unroll
        for (unsigned j = 0; j < 16; ++j) { const unsigned c = xb_ld(&bar[XB_XCNT(j)]); sum += c; cnt += (c > 0u) ? 1u : 0u; mine = (j == x) ? c : mine; }
        if (sum == G) break;
        __builtin_amdgcn_s_sleep(1);
        if ((++sp & 255u) == 0u) { if (xb_ld(&bar[XB_TMO])) break; if (sp > XB_SPIN_CAP) { atomicAdd(&bar[XB_TMO], 1u); break; } }
    }
    nloc = mine > 0u ? mine : 1u; nx = cnt > 0u ? cnt : 1u;
}
__device__ __forceinline__ void xcd_barrier(const XcdBarrier& b) {
    asm volatile("s_waitcnt vmcnt(0)" ::: "memory");
    __syncthreads();
    if (threadIdx.x == 0) {
        unsigned* bar = b.bar;
        __builtin_amdgcn_s_waitcnt(0);
        unsigned nloc = b.st[0], nx = b.st[1];
        if (nloc == 0u) { xcd_barrier_complete(bar, b.x, nloc, nx); b.st[0] = nloc; b.st[1] = nx; }
        const unsigned old = xb_add(&bar[XB_XSUB(b.x)], 1u);
        const unsigned gen = old / nloc;
        if (old + 1u == (gen + 1u) * nloc) {
            __builtin_amdgcn_fence(__ATOMIC_RELEASE, "agent");
            asm volatile("s_waitcnt vmcnt(0)" ::: "memory");
            const unsigned og = xb_add(&bar[XB_TOP], 1u);
            const unsigned tg = og / nx;
            if (og + 1u == (tg + 1u) * nx) xb_add(&bar[XB_TOPGEN], 1u);
            else XB_SPIN(xb_ld(&bar[XB_TOPGEN]) == tg, bar);
            __builtin_amdgcn_fence(__ATOMIC_ACQUIRE, "agent");
            xb_add(&bar[XB_XGEN(b.x)], 1u);
            asm volatile("s_waitcnt vmcnt(0)" ::: "memory");
        } else {
            XB_SPIN(xb_ld(&bar[XB_XGEN(b.x)]) == gen, bar);
            __builtin_amdgcn_fence(__ATOMIC_ACQUIRE, "agent");
            asm volatile("s_waitcnt vmcnt(0)" ::: "memory");
        }
    }
    __syncthreads();
}

struct Frame {
    LAS unsigned char* lds;
    volatile LAS unsigned* MISC;
    gu32* ctl;
    int vcu, G;
    unsigned char* ws;
    float* out;
};
__device__ __forceinline__ const float* ldp(const Frame& F, int k) {
    volatile LAS unsigned* p = F.MISC + 32 + 2 * k; unsigned lo = p[0], hi = p[1];
    lo = __builtin_amdgcn_readfirstlane(lo); hi = __builtin_amdgcn_readfirstlane(hi);
    return (const float*)(const GAS float*)(((unsigned long long)hi << 32) | (unsigned long long)lo);
}
__device__ __forceinline__ void unpack8(const u32x4 w, float* f) {
    f[0] = bf_lo(w.x); f[1] = bf_hi(w.x); f[2] = bf_lo(w.y); f[3] = bf_hi(w.y); f[4] = bf_lo(w.z); f[5] = bf_hi(w.z); f[6] = bf_lo(w.w); f[7] = bf_hi(w.w);
}
__device__ __forceinline__ u32x4 pack8f(const float* f) { u32x4 w; w.x = pk2(f[0], f[1]); w.y = pk2(f[2], f[3]); w.z = pk2(f[4], f[5]); w.w = pk2(f[6], f[7]); return w; }

__device__ __forceinline__ void p0_transpose_item(const float* W, int K, int N, bf16_t* WT, int row_off, LAS float* scr, int item, int lane) {
    const int nblk = N / 32, kb = item / nblk, nb = item % nblk, k0 = 64 * kb, n0 = 32 * nb;
#pragma unroll 8
    for (int i = 0; i < 32; ++i) { const int kk = 2 * i + (lane >> 5); scr[kk * 33 + (lane & 31)] = W[(size_t)(k0 + kk) * N + n0 + (lane & 31)]; }
    LDS_WAIT(); asm volatile("" ::: "memory");
    const int c = lane & 7;
#pragma unroll
    for (int j = 0; j < 4; ++j) { const int n = (lane >> 3) + 8 * j; const LAS float* s = scr + (8 * c) * 33 + n;
        u32x4 o; o.x = pk2(s[0 * 33], s[1 * 33]); o.y = pk2(s[2 * 33], s[3 * 33]); o.z = pk2(s[4 * 33], s[5 * 33]); o.w = pk2(s[6 * 33], s[7 * 33]);
        *(GAS u32x4*)(WT + (size_t)(row_off + n0 + n) * K + k0 + 8 * c) = o; }
    LDS_WAIT(); asm volatile("" ::: "memory");
}
__device__ __forceinline__ void rms_row_to_bf16(int lane, const float* xrow, const float* g, bf16_t* orow) {
    const f32x4* xr = (const f32x4*)xrow + lane; const f32x4* gr = (const f32x4*)g + lane;
    f32x4 v[4]; float s = 0.f;
#pragma unroll
    for (int j = 0; j < 4; ++j) { v[j] = xr[64 * j]; s += (v[j].x * v[j].x + v[j].y * v[j].y) + (v[j].z * v[j].z + v[j].w * v[j].w); }
    const float rstd = 1.f / sqrtf(wave_sum(s) * (1.f / DM) + EPS);
    unsigned long long* o8 = (unsigned long long*)orow + lane;
#pragma unroll
    for (int j = 0; j < 4; ++j) { const f32x4 gg = gr[64 * j];
        o8[64 * j] = (unsigned long long)pk2(v[j].x * rstd * gg.x, v[j].y * rstd * gg.y) | ((unsigned long long)pk2(v[j].z * rstd * gg.z, v[j].w * rstd * gg.w) << 32); }
}
__device__ __forceinline__ void rms_row_f32(int lane, const float* xrow, const float* g, float* orow) {
    const f32x4* xr = (const f32x4*)xrow + lane; const f32x4* gr = (const f32x4*)g + lane;
    f32x4 v[4]; float s = 0.f;
#pragma unroll
    for (int j = 0; j < 4; ++j) { v[j] = xr[64 * j]; s += (v[j].x * v[j].x + v[j].y * v[j].y) + (v[j].z * v[j].z + v[j].w * v[j].w); }
    const float rstd = 1.f / sqrtf(wave_sum(s) * (1.f / DM) + EPS);
    f32x4* o = (f32x4*)orow + lane;
#pragma unroll
    for (int j = 0; j < 4; ++j) o[64 * j] = v[j] * rstd * gr[64 * j];
}

__device__ __forceinline__ void p0_prologue(Frame& F) {
    const int tid = tid_(), lane = tid & 63, wave = __builtin_amdgcn_readfirstlane(tid >> 6);
    LAS float* scr = (LAS float*)(F.lds + wave * 16384);
    const int gw = F.vcu * NWAVES + wave, NGW = F.G * NWAVES;
    const float* w_in = ldp(F, 2); const float* w_uq = ldp(F, 5); const float* w_ukv = ldp(F, 7); const float* w_oa = ldp(F, 8); const float* w_ob = ldp(F, 9);
    const float* w_out = ldp(F, 10); const float* w_up = ldp(F, 12); const float* w_dn = ldp(F, 15);
    bf16_t* Win = (bf16_t*)(F.ws + WS_WIN); bf16_t* Wuq = (bf16_t*)(F.ws + WS_WUQ); bf16_t* Wukv = (bf16_t*)(F.ws + WS_WUKV); bf16_t* Woa = (bf16_t*)(F.ws + WS_WOA);
    bf16_t* Wob = (bf16_t*)(F.ws + WS_WOB); bf16_t* Wout = (bf16_t*)(F.ws + WS_WOUT); bf16_t* Wup = (bf16_t*)(F.ws + WS_WUP); bf16_t* Wdn = (bf16_t*)(F.ws + WS_WDN);
    constexpr int NIN0 = 5824;
    constexpr int I_IN = (DM / 64) * (NIN0 / 32), I_UQ = (QL / 64) * (NQ / 32), I_UKV = (KVL / 64) * (NKV / 32), I_O = (DM / 64) * (DM / 32), I_UP = (DM / 64) * (NUP / 32), I_DN = (DFF / 64) * (DM / 32);
    constexpr int NITEMS = I_IN + I_UQ + I_UKV + 3 * I_O + I_UP + I_DN;
    for (int it = gw; it < NITEMS; it += NGW) {
        int r = it;
        if (r < I_IN) { const int nb = r % (NIN0 / 32); p0_transpose_item(w_in, DM, NIN0, Win, (nb * 32 >= 704) ? 64 : 0, scr, r, lane); continue; } r -= I_IN;
        if (r < I_UQ) { p0_transpose_item(w_uq, QL, NQ, Wuq, 0, scr, r, lane); continue; } r -= I_UQ;
        if (r < I_UKV) { p0_transpose_item(w_ukv, KVL, NKV, Wukv, 0, scr, r, lane); continue; } r -= I_UKV;
        if (r < I_O) { p0_transpose_item(w_oa, DM, DM, Woa, 0, scr, r, lane); continue; } r -= I_O;
        if (r < I_O) { p0_transpose_item(w_ob, DM, DM, Wob, 0, scr, r, lane); continue; } r -= I_O;
        if (r < I_O) { p0_transpose_item(w_out, DM, DM, Wout, 0, scr, r, lane); continue; } r -= I_O;
        if (r < I_UP) { p0_transpose_item(w_up, DM, NUP, Wup, 0, scr, r, lane); continue; } r -= I_UP;
        p0_transpose_item(w_dn, DFF, DM, Wdn, 0, scr, r, lane);
    }
    const int gt = F.vcu * (NWAVES * 64) + tid, NGT = F.G * NWAVES * 64;
    for (int i = gt; i < 64 * DM / 8; i += NGT) *(GAS u32x4*)(Win + (size_t)704 * DM + (size_t)i * 8) = (u32x4){0u, 0u, 0u, 0u};
    float* csb = (float*)(F.ws + WS_CSB); float* csa = (float*)(F.ws + WS_CSA);
    for (int i = gt; i < SEQ * 64; i += NGT) { const int pos = i >> 6, k = i & 63; const float inv = powf(10000.0f, -(float)k / 64.0f); const float ang = (float)pos * inv;
        csb[i] = cosf(ang); csb[SEQ * 64 + i] = sinf(ang); }
    for (int i = gt; i < SEQ * 32; i += NGT) { const int pos = i >> 5, k = i & 31; const float inv = powf(10000.0f, -(float)k / 32.0f); const float ang = (float)pos * inv;
        csa[i] = cosf(ang); csa[SEQ * 32 + i] = sinf(ang); }
    bf16_t* XN = (bf16_t*)(F.ws + WS_XN);
    { const float* x_ = ldp(F, 0); const float* g_ = ldp(F, 1);
      for (int m = gw; m < M; m += NGW) rms_row_to_bf16(lane, x_ + (size_t)m * DM, g_, XN + (size_t)m * DM); }
}

__device__ __forceinline__ void rope8(const u32x4 x1, const u32x4 x2, const float* cs, const float* sn, u32x4& y1, u32x4& y2, float* acc1, float* acc2) {
    float a[8], b[8], o1[8], o2[8]; unpack8(x1, a); unpack8(x2, b);
    const f32x4 c0 = *(const f32x4*)cs, c1 = *(const f32x4*)(cs + 4), s0 = *(const f32x4*)sn, s1 = *(const f32x4*)(sn + 4);
#pragma unroll
    for (int j = 0; j < 8; ++j) { const float c = j < 4 ? c0[j & 3] : c1[j & 3], s = j < 4 ? s0[j & 3] : s1[j & 3]; o1[j] = a[j] * c - b[j] * s; o2[j] = a[j] * s + b[j] * c; }
    y1 = pack8f(o1); y2 = pack8f(o2);
    if (acc1) {
        float r1[8], r2[8]; unpack8(y1, r1); unpack8(y2, r2);
#pragma unroll
        for (int j = 0; j < 8; ++j) { acc1[j] += r1[j]; acc2[j] += r2[j]; }
    }
}
__device__ __forceinline__ void p1e_phase(Frame& F) {
    bf16_t* LAT = (bf16_t*)(F.ws + WS_LAT); bf16_t* MQKV = (bf16_t*)(F.ws + WS_MQKV); bf16_t* KM = (bf16_t*)(F.ws + WS_KM);
    const float* csb = (const float*)(F.ws + WS_CSB); const float* csa = (const float*)(F.ws + WS_CSA);
    const float* g_q = ldp(F, 4); const float* g_kv = ldp(F, 6);
    const int tid = tid_(), lane = tid & 63, wave = __builtin_amdgcn_readfirstlane(tid >> 6);
    for (int u = F.vcu; u < 256; u += F.G) {
        const int rb = u >> 2, cg = u & 3, m0 = rb * 256, pos0 = (rb & 31) * 256, b = rb >> 5, blk = rb & 31;
        if (cg == 0) {
            float gq[8], gk[8];
#pragma unroll
            for (int j = 0; j < 8; ++j) { gq[j] = lane < 48 ? g_q[8 * lane + j] : 0.f; gk[j] = lane < 32 ? g_kv[8 * lane + j] : 0.f; }
            for (int it = 0; it < 32; it += 4) {
                u32x4 a[4], k[4], c1[4], c2[4];
#pragma unroll
                for (int q = 0; q < 4; ++q) { bf16_t* row = LAT + (size_t)(m0 + wave * 32 + it + q) * NLAT;
                    a[q] = lane < 48 ? *(const u32x4*)(row + 8 * lane) : (u32x4){0u, 0u, 0u, 0u};
                    k[q] = lane < 32 ? *(const u32x4*)(row + QL + 8 * lane) : (u32x4){0u, 0u, 0u, 0u};
                    if (lane < 4) { c1[q] = *(const u32x4*)(row + QL + KVL + 8 * lane); c2[q] = *(const u32x4*)(row + QL + KVL + 32 + 8 * lane); } }
#pragma unroll
                for (int q = 0; q < 4; ++q) { bf16_t* row = LAT + (size_t)(m0 + wave * 32 + it + q) * NLAT; const int pos = pos0 + wave * 32 + it + q;
                    float fa[8], fk[8]; unpack8(a[q], fa); unpack8(k[q], fk);
                    float sa = 0.f, sk = 0.f;
#pragma unroll
                    for (int j = 0; j < 8; ++j) { sa += fa[j] * fa[j]; sk += fk[j] * fk[j]; }
                    const float ra = 1.f / sqrtf(wave_sum(sa) * (1.f / QL) + EPS), rk = 1.f / sqrtf(wave_sum(sk) * (1.f / KVL) + EPS);
#pragma unroll
                    for (int j = 0; j < 8; ++j) { fa[j] *= ra * gq[j]; fk[j] *= rk * gk[j]; }
                    if (lane < 48) *(u32x4*)(row + 8 * lane) = pack8f(fa);
                    if (lane < 32) *(u32x4*)(row + QL + 8 * lane) = pack8f(fk);
                    if (lane < 4) { u32x4 y1, y2; rope8(c1[q], c2[q], csa + (size_t)pos * 32 + 8 * lane, csa + (size_t)SEQ * 32 + (size_t)pos * 32 + 8 * lane, y1, y2, nullptr, nullptr);
                        *(u32x4*)(row + QL + KVL + 8 * lane) = y1; *(u32x4*)(row + QL + KVL + 32 + 8 * lane) = y2; } }
            }
        } else if (cg == 1) {
            const int head = lane >> 3, c = lane & 7;
            for (int it = 0; it < 32; it += 4) {
                u32x4 x1[4], x2[4];
#pragma unroll
                for (int q = 0; q < 4; ++q) { const bf16_t* p = MQKV + (size_t)(m0 + wave * 32 + it + q) * NMOBA + head * 128 + 8 * c; x1[q] = *(const u32x4*)p; x2[q] = *(const u32x4*)(p + 64); }
#pragma unroll
                for (int q = 0; q < 4; ++q) { bf16_t* p = MQKV + (size_t)(m0 + wave * 32 + it + q) * NMOBA + head * 128 + 8 * c; const int pos = pos0 + wave * 32 + it + q;
                    u32x4 y1, y2; rope8(x1[q], x2[q], csb + (size_t)pos * 64 + 8 * c, csb + (size_t)SEQ * 64 + (size_t)pos * 64 + 8 * c, y1, y2, nullptr, nullptr);
                    *(u32x4*)p = y1; *(u32x4*)(p + 64) = y2; }
            }
        } else {
            const int rsub = lane >> 5, head = 4 * (cg - 2) + ((lane >> 3) & 3), c = lane & 7;
            float s1[8], s2[8];
#pragma unroll
            for (int j = 0; j < 8; ++j) { s1[j] = 0.f; s2[j] = 0.f; }
            for (int it = 0; it < 16; it += 4) {
                u32x4 x1[4], x2[4];
#pragma unroll
                for (int q = 0; q < 4; ++q) { const bf16_t* p = MQKV + (size_t)(m0 + wave * 32 + 2 * (it + q) + rsub) * NMOBA + 1024 + head * 128 + 8 * c; x1[q] = *(const u32x4*)p; x2[q] = *(const u32x4*)(p + 64); }
#pragma unroll
                for (int q = 0; q < 4; ++q) { bf16_t* p = MQKV + (size_t)(m0 + wave * 32 + 2 * (it + q) + rsub) * NMOBA + 1024 + head * 128 + 8 * c; const int pos = pos0 + wave * 32 + 2 * (it + q) + rsub;
                    u32x4 y1, y2; rope8(x1[q], x2[q], csb + (size_t)pos * 64 + 8 * c, csb + (size_t)SEQ * 64 + (size_t)pos * 64 + 8 * c, y1, y2, s1, s2);
                    *(u32x4*)p = y1; *(u32x4*)(p + 64) = y2; }
            }
            LAS float* part = (LAS float*)F.lds;
#pragma unroll
            for (int j = 0; j < 8; ++j) { s1[j] += __shfl_xor(s1[j], 32); s2[j] += __shfl_xor(s2[j], 32); }
            if (lane < 32) {
#pragma unroll
                for (int j = 0; j < 8; ++j) { part[(wave * 32 + lane) * 16 + j] = s1[j]; part[(wave * 32 + lane) * 16 + 8 + j] = s2[j]; } }
            LDS_WAIT(); __syncthreads();
            { const int l2 = tid >> 4, v = tid & 15; float s = 0.f;
#pragma unroll
              for (int w = 0; w < 8; ++w) s += part[(w * 32 + l2) * 16 + v];
              const int hd = 4 * (cg - 2) + (l2 >> 3), cc = l2 & 7, dim = v < 8 ? 8 * cc + v : 64 + 8 * cc + (v - 8);
              KM[((size_t)(b * 8 + hd) * 32 + blk) * 128 + dim] = (bf16_t)f2bf(s * (1.f / 256.f)); }
            LDS_WAIT(); __syncthreads();
        }
    }
}

__device__ __forceinline__ void p4e_phase(Frame& F, int b) {
    const bf16_t* G = (const bf16_t*)(F.ws + WS_G); bf16_t* ACT = (bf16_t*)(F.ws + WS_ACT) + (size_t)b * SEQ * DFF;
    const float* cw = ldp(F, 13); const float* cb = ldp(F, 14);
    const int gt = F.vcu * (NWAVES * 64) + tid_(), NGT = F.G * NWAVES * 64;
    constexpr int NCH = DFF / 8, RG = 8, NTASK = (SEQ / RG) * NCH;
    for (int task = gt; task < NTASK; task += NGT) {
        const int rg = task / NCH, ch = task - rg * NCH, c = ch * 8, r0 = rg * RG;
        float w0a[8], w1a[8], w2a[8], ba[8], w0b[8], w1b[8], w2b[8], bb[8];
#pragma unroll
        for (int j = 0; j < 8; ++j) { w0a[j] = cw[c + j]; w1a[j] = cw[NUP + c + j]; w2a[j] = cw[2 * NUP + c + j]; ba[j] = cb[c + j];
            w0b[j] = cw[DFF + c + j]; w1b[j] = cw[NUP + DFF + c + j]; w2b[j] = cw[2 * NUP + DFF + c + j]; bb[j] = cb[DFF + c + j]; }
        float p2a[8], p1a[8], p2b[8], p1b[8];
        { u32x4 z = {0u, 0u, 0u, 0u};
          const u32x4 t2a = r0 >= 2 ? *(const u32x4*)(G + (size_t)(r0 - 2) * NUP + c) : z, t2b = r0 >= 2 ? *(const u32x4*)(G + (size_t)(r0 - 2) * NUP + DFF + c) : z;
          const u32x4 t1a = r0 >= 1 ? *(const u32x4*)(G + (size_t)(r0 - 1) * NUP + c) : z, t1b = r0 >= 1 ? *(const u32x4*)(G + (size_t)(r0 - 1) * NUP + DFF + c) : z;
          unpack8(t2a, p2a); unpack8(t2b, p2b); unpack8(t1a, p1a); unpack8(t1b, p1b); }
        u32x4 ca[RG], cbv[RG];
#pragma unroll
        for (int r = 0; r < RG; ++r) { ca[r] = *(const u32x4*)(G + (size_t)(r0 + r) * NUP + c); cbv[r] = *(const u32x4*)(G + (size_t)(r0 + r) * NUP + DFF + c); }
#pragma unroll
        for (int r = 0; r < RG; ++r) {
            float xa[8], xb[8], o[8]; unpack8(ca[r], xa); unpack8(cbv[r], xb);
#pragma unroll
            for (int j = 0; j < 8; ++j) {
                const float u1 = ba[j] + w0a[j] * p2a[j] + w1a[j] * p1a[j] + w2a[j] * xa[j];
                const float u2 = bb[j] + w0b[j] * p2b[j] + w1b[j] * p1b[j] + w2b[j] * xb[j];
                o[j] = u1 * sigmoidf_(u1) * u2;
                p2a[j] = p1a[j]; p1a[j] = xa[j]; p2b[j] = p1b[j]; p1b[j] = xb[j];
            }
            *(u32x4*)(ACT + (size_t)(r0 + r) * DFF + c) = pack8f(o);
        }
    }
}

constexpr int N_PHASES = 16;
struct Args { const float* in[17]; float* out; unsigned char* ws; int ph_lo, ph_hi, li, pad; };
__global__ void __launch_bounds__(NWAVES * 64, 2) fwd_kernel(Args args) {
    extern __shared__ __attribute__((aligned(16))) unsigned char lds[];
    Frame F;
    F.lds = (LAS unsigned char*)lds;
    F.MISC = (volatile LAS unsigned*)(F.lds + MISC_OFF);
    F.G = gridDim.x; { const int bx = blockIdx.x; F.vcu = (F.G % 8 == 0) ? (bx % 8) * (F.G / 8) + bx / 8 : bx; }
    F.ws = args.ws; F.ctl = (gu32*)(args.ws + WS_CTL); F.out = args.out;
    for (int u = threadIdx.x; u < (LDS_BYTES - LDSCTL_OFF) / 4; u += NWAVES * 64) ((LAS unsigned*)(F.lds + LDSCTL_OFF))[u] = 0u;
    __syncthreads();
    if (threadIdx.x == 0) {
#pragma unroll
        for (int i = 0; i < 17; ++i) { const unsigned long long v = (unsigned long long)(uintptr_t)args.in[i]; F.MISC[32 + 2 * i] = (unsigned)v; F.MISC[33 + 2 * i] = (unsigned)(v >> 32); } }
    __syncthreads();
    const int lo = args.ph_lo, hi = args.ph_hi;
    const bool multi = (hi - lo) > 1;
    XcdBarrier bar; bar.bar = (unsigned*)(F.ctl + CW_BAR); bar.x = 0; bar.st = nullptr;
    if (multi) bar = xcd_barrier_post((unsigned*)(F.ctl + CW_BAR), F.MISC + 8);
#ifndef PHMASK
#define PHMASK 0xffff
#endif
#define IN(k) (((PHMASK >> (k)) & 1) && lo <= (k) && (k) < hi)
#define SEAM(k) do { if (IN((k) + 1)) xcd_barrier(bar); } while (0)
#define PH_BEGIN unsigned long long ws__ = (unsigned long long)(uintptr_t)F.ws; asm volatile("" : "+s"(ws__)); unsigned char* ws = (unsigned char*)(GAS unsigned char*)ws__; \
    unsigned long long out__ = (unsigned long long)(uintptr_t)F.out; asm volatile("" : "+s"(out__)); float* outp = (float*)(GAS float*)out__; bf16_t* GATE = (bf16_t*)outp; (void)GATE; (void)ws;

    if (IN(0)) { p0_prologue(F); SEAM(0); }

    if (IN(1)) { PH_BEGIN
        pg8::Gemm g{(const bf16_t*)(ws + WS_XN), (const bf16_t*)(ws + WS_WIN), M, NIN, DM, DM}; pg8::StaticOrder S; S.init(M, NIN, F.G, (int)blockIdx.x);
        pg8::EpiBf16R E{(bf16_t*)(ws + WS_LAT), NLAT, 3, (bf16_t*)(ws + WS_MQKV), NMOBA, 15, GATE, NGATE};
        pg8::gemm_phase(F.lds, g, S, E);
        SEAM(1);
    }
    if (IN(2)) { p1e_phase(F); SEAM(2); }

    if (IN(3)) { PH_BEGIN
        for (int it = F.vcu; it < 256; it += F.G) {
            const int bh = it >> 4, s = it & 15, b = bh >> 3, h = bh & 7;
            att::Head T;
            const bf16_t* base = (const bf16_t*)(ws + WS_MQKV) + (size_t)b * SEQ * NMOBA + h * 128;
            T.Q = base; T.K = base + 1024; T.KR = nullptr; T.V = base + 2048;
            T.O = (bf16_t*)(ws + WS_YB) + (size_t)b * SEQ * DM + h * 128; T.cosT = nullptr; T.sinT = nullptr;
            T.KM = (const bf16_t*)(ws + WS_KM) + (size_t)bh * 32 * 128;
#pragma unroll 1
            for (int pass = 0; pass < 2; ++pass) att::attn_block<true>(T, pass ? s : 31 - s, (char*)lds);
        }
        SEAM(3);
    }
    if (IN(4)) { PH_BEGIN
        { pg8::Gemm g{(const bf16_t*)(ws + WS_LAT), (const bf16_t*)(ws + WS_WUQ), M, NQ, QL, NLAT}; pg8::StaticOrder S; S.init(M, NQ, F.G, (int)blockIdx.x);
          pg8::EpiBf16R E{(bf16_t*)(ws + WS_Q), NQ, 1 << 20, nullptr, 0, 1 << 20, nullptr, 0};
          pg8::gemm_phase(F.lds, g, S, E); }
        { pg8::Gemm g{(const bf16_t*)(ws + WS_LAT) + QL, (const bf16_t*)(ws + WS_WUKV), M, NKV, KVL, NLAT}; pg8::StaticOrder S; S.init(M, NKV, F.G, (int)blockIdx.x);
          pg8::EpiBf16R E{(bf16_t*)(ws + WS_KV), NKV, 1 << 20, nullptr, 0, 1 << 20, nullptr, 0};
          pg8::gemm_phase(F.lds, g, S, E); }
        SEAM(4);
    }
    if (IN(5)) { PH_BEGIN
        for (int it = F.vcu; it < 256; it += F.G) {
            const int bh = it >> 4, s = it & 15, b = bh >> 3, h = bh & 7;
            att::Head T;
            T.Q = (const bf16_t*)(ws + WS_Q) + (size_t)b * SEQ * NQ + h * 192;
            T.K = (const bf16_t*)(ws + WS_KV) + (size_t)b * SEQ * NKV + h * 256;
            T.KR = (const bf16_t*)(ws + WS_LAT) + (size_t)b * SEQ * NLAT + QL + KVL;
            T.V = T.K + 128;
            T.O = (bf16_t*)(ws + WS_YA) + (size_t)b * SEQ * DM + h * 128;
            T.cosT = (const float*)(ws + WS_CSA); T.sinT = T.cosT + (size_t)SEQ * 32; T.KM = nullptr;
#pragma unroll 1
            for (int pass = 0; pass < 2; ++pass) att::attn_block<false>(T, pass ? s : 31 - s, (char*)lds);
        }
        SEAM(5);
    }
    if (IN(6)) { PH_BEGIN
        pg8::Gemm g{(const bf16_t*)(ws + WS_YA), (const bf16_t*)(ws + WS_WOA), M, DM, DM, DM}; pg8::StaticOrder S; S.init(M, DM, F.G, (int)blockIdx.x);
        pg8::EpiGateF32 E{(float*)(ws + WS_T), GATE, ldp(F, 3), 0};
        pg8::gemm_phase(F.lds, g, S, E);
        SEAM(6);
    }
    if (IN(7)) { PH_BEGIN
        pg8::Gemm g{(const bf16_t*)(ws + WS_YB), (const bf16_t*)(ws + WS_WOB), M, DM, DM, DM}; pg8::StaticOrder S; S.init(M, DM, F.G, (int)blockIdx.x);
        pg8::EpiGateAddBf16 E{(bf16_t*)(ws + WS_Z), (const float*)(ws + WS_T), GATE, ldp(F, 3), DM};
        pg8::gemm_phase(F.lds, g, S, E);
        SEAM(7);
    }
    if (IN(8)) { PH_BEGIN
        pg8::Gemm g{(const bf16_t*)(ws + WS_Z), (const bf16_t*)(ws + WS_WOUT), M, DM, DM, DM}; pg8::StaticOrder S; S.init(M, DM, F.G, (int)blockIdx.x);
        pg8::EpiResF32 E{ldp(F, 0), outp};
        pg8::gemm_phase(F.lds, g, S, E);
        SEAM(8);
    }
    if (IN(9)) { PH_BEGIN
        const int tid = tid_(), lane = tid & 63, wave = __builtin_amdgcn_readfirstlane(tid >> 6);
        const int gw = F.vcu * NWAVES + wave, NGW = F.G * NWAVES; bf16_t* XN2 = (bf16_t*)(ws + WS_XN2); const float* g_ = ldp(F, 11);
        for (int m = gw; m < M; m += NGW) rms_row_to_bf16(lane, outp + (size_t)m * DM, g_, XN2 + (size_t)m * DM);
        SEAM(9);
    }
#pragma unroll 1
    for (int b = 0; b < 2; ++b) {
        if (IN(10 + 2 * b)) { PH_BEGIN
            pg8::Gemm g{(const bf16_t*)(ws + WS_XN2) + (size_t)b * SEQ * DM, (const bf16_t*)(ws + WS_WUP), SEQ, NUP, DM, DM}; pg8::StaticOrder S; S.init(SEQ, NUP, F.G, (int)blockIdx.x);
            pg8::EpiBf16R E{(bf16_t*)(ws + WS_G), NUP, 1 << 20, nullptr, 0, 1 << 20, nullptr, 0};
            pg8::gemm_phase(F.lds, g, S, E);
            SEAM(10 + 2 * b);
        }
        if (IN(11 + 2 * b)) { p4e_phase(F, b); SEAM(11 + 2 * b); }
    }
    if (IN(14)) { PH_BEGIN
        pg8::Gemm g{(const bf16_t*)(ws + WS_ACT), (const bf16_t*)(ws + WS_WDN), M, DM, DFF, DFF}; pg8::StaticOrder S; S.init(M, DM, F.G, (int)blockIdx.x);
        pg8::EpiResF32 E{outp, outp};
        pg8::gemm_phase(F.lds, g, S, E);
        SEAM(14);
    }
    if (IN(15)) { PH_BEGIN
        const int tid = tid_(), lane = tid & 63, wave = __builtin_amdgcn_readfirstlane(tid >> 6);
        const int gw = F.vcu * NWAVES + wave, NGW = F.G * NWAVES; const float* g_ = ldp(F, 16);
        for (int m = gw; m < M; m += NGW) rms_row_f32(lane, outp + (size_t)m * DM, g_, outp + (size_t)m * DM);
    }
#undef IN
#undef SEAM
}

extern "C" void kernel_launch(void* const* d_in, const int* in_sizes, int n_in, void* d_out, int out_size, void* d_ws, size_t ws_size, hipStream_t stream) {
    static int grid = 0;
    if (grid == 0) {
        if (n_in != 17 || in_sizes[0] != M * DM || out_size != M * DM || ws_size < WS_END) {
            fprintf(stderr, "kernel_launch: unexpected shapes: n_in %d in0 %d out %d ws %zu; nothing launched\n", n_in, n_in > 0 ? in_sizes[0] : -1, out_size, ws_size); grid = -1; return; }
        int dev = 0, cus = 0;
        if (hipGetDevice(&dev) != hipSuccess || hipDeviceGetAttribute(&cus, hipDeviceAttributeMultiprocessorCount, dev) != hipSuccess) { grid = -1; return; }
        if (hipFuncSetAttribute((const void*)fwd_kernel, hipFuncAttributeMaxDynamicSharedMemorySize, LDS_BYTES) != hipSuccess) { fprintf(stderr, "kernel_launch: hipFuncSetAttribute failed\n"); grid = -1; return; }
        int per_cu = 0;
        if (hipOccupancyMaxActiveBlocksPerMultiprocessor(&per_cu, (const void*)fwd_kernel, NWAVES * 64, LDS_BYTES) != hipSuccess || per_cu < 1)
            fprintf(stderr, "kernel_launch: note: occupancy query reports %d workgroups per CU\n", per_cu);
        (void)hipGetLastError();
        grid = cus;
    }
    if (grid < 0) return;
    if (hipMemsetAsync((char*)d_ws + WS_CTL, 0, CTL_ZERO_BYTES, stream) != hipSuccess) { fprintf(stderr, "kernel_launch: memset failed\n"); return; }
    Args a{};
    for (int i = 0; i < 17; ++i) a.in[i] = (const float*)d_in[i];
    a.out = (float*)d_out; a.ws = (unsigned char*)d_ws;
#if MK_N_LAUNCHES == 1
    a.ph_lo = 0; a.ph_hi = N_PHASES; a.li = 0;
    hipLaunchKernelGGL(fwd_kernel, dim3(grid), dim3(NWAVES * 64), LDS_BYTES, stream, a);
#else
    for (int li = 0; li < N_PHASES; ++li) { a.ph_lo = li; a.ph_hi = li + 1; a.li = li;
        hipLaunchKernelGGL(fwd_kernel, dim3(grid), dim3(NWAVES * 64), LDS_BYTES, stream, a); }
#endif
}
```

```cpp
#include <hip/hip_runtime.h>
#include <cstdio>
#include <cstdint>

#ifndef MOBA_DENSE
#define MOBA_DENSE 0
#endif
#ifndef MK_N_LAUNCHES
#define MK_N_LAUNCHES 1
#endif

#define GAS __attribute__((address_space(1)))
#define LAS __attribute__((address_space(3)))
typedef unsigned short bf16_t;
typedef short bf16x8 __attribute__((ext_vector_type(8)));
typedef short s16x4 __attribute__((ext_vector_type(4)));
typedef float f32x4 __attribute__((ext_vector_type(4)));
typedef float f32x2 __attribute__((ext_vector_type(2)));
typedef float f32x16 __attribute__((ext_vector_type(16)));
typedef unsigned u32x4 __attribute__((ext_vector_type(4)));
typedef unsigned u32x2 __attribute__((ext_vector_type(2)));

constexpr int DM = 1024, BATCH = 2, SEQ = 8192, M = BATCH * SEQ;
constexpr int QL = 384, KVL = 256, KPE = 64;
constexpr int NLAT = 768;
constexpr int NMOBA = 3072, NGATE = 2048;
constexpr int NIN = NLAT + NMOBA + NGATE;
constexpr int NQ = 1536, NKV = 2048;
constexpr int DFF = 2816, NUP = 2 * DFF;
constexpr int NH = 8;
constexpr float EPS = 1e-6f;
constexpr int NWAVES = 8;

constexpr size_t MiB = 1u << 20;
constexpr size_t WS_CTL = 0, CTL_ZERO_BYTES = 1 * MiB;
constexpr size_t WS_WIN = 1 * MiB;
constexpr size_t WS_WUQ = WS_WIN + (size_t)NIN * DM * 2;
constexpr size_t WS_WUKV = WS_WUQ + (size_t)NQ * QL * 2;
constexpr size_t WS_WOA = WS_WUKV + (size_t)NKV * KVL * 2;
constexpr size_t WS_WOB = WS_WOA + (size_t)DM * DM * 2;
constexpr size_t WS_WOUT = WS_WOB + (size_t)DM * DM * 2;
constexpr size_t WS_WUP = WS_WOUT + (size_t)DM * DM * 2;
constexpr size_t WS_WDN = WS_WUP + (size_t)NUP * DM * 2;
constexpr size_t WS_CSB = WS_WDN + (size_t)DM * DFF * 2;
constexpr size_t WS_CSA = WS_CSB + (size_t)SEQ * 64 * 4 * 2;
constexpr size_t WS_KM = WS_CSA + (size_t)SEQ * 32 * 4 * 2;
constexpr size_t WS_FIXED_END = WS_KM + (size_t)16 * 32 * 128 * 2;
constexpr size_t A0 = 44 * MiB;
static_assert(WS_FIXED_END <= A0, "fixed region");
constexpr size_t WS_LAT = A0;
constexpr size_t WS_MQKV = A0 + 24 * MiB;
constexpr size_t WS_YB = A0 + 120 * MiB;
constexpr size_t WS_XN = A0 + 152 * MiB;
constexpr size_t WS_Q = A0 + 152 * MiB;
constexpr size_t WS_KV = A0 + 24 * MiB;
constexpr size_t WS_YA = A0 + 88 * MiB;
constexpr size_t WS_T = A0 + 24 * MiB;
constexpr size_t WS_Z = A0 + 152 * MiB;
constexpr size_t WS_XN2 = A0;
constexpr size_t WS_G = A0 + 32 * MiB;
constexpr size_t WS_ACT = A0 + 120 * MiB;
constexpr size_t WS_END = 256 * MiB;
static_assert(WS_ACT + (size_t)M * DFF * 2 <= WS_END && WS_Q + (size_t)M * NQ * 2 <= WS_END, "ws map");

constexpr int CW_TMO = 0, CW_CODE = 1, CW_BAR = 4096;

constexpr int RING_BYTES = 131072;
constexpr int LDS_BYTES = 163840;
constexpr int LDSCTL_OFF = LDS_BYTES - 1024, MISC_OFF = LDSCTL_OFF + 320;

#define RLX_AGENT __ATOMIC_RELAXED, __HIP_MEMORY_SCOPE_AGENT
#define LDS_WAIT() asm volatile("s_waitcnt lgkmcnt(0)" ::: "memory")
#define VM_WAIT() asm volatile("s_waitcnt vmcnt(0)" ::: "memory")

__device__ __forceinline__ unsigned f2bf(float f) { unsigned u = __builtin_bit_cast(unsigned, f); return (u + 0x7fffu + ((u >> 16) & 1u)) >> 16; }
__device__ __forceinline__ unsigned pk2(float lo, float hi) { return f2bf(lo) | (f2bf(hi) << 16); }
__device__ __forceinline__ float bf_lo(unsigned w) { return __builtin_bit_cast(float, w << 16); }
__device__ __forceinline__ float bf_hi(unsigned w) { return __builtin_bit_cast(float, w & 0xffff0000u); }
__device__ __forceinline__ unsigned cvt_pk_bf16(float lo, float hi) { unsigned r; asm volatile("v_cvt_pk_bf16_f32 %0, %1, %2" : "=v"(r) : "v"(lo), "v"(hi)); return r; }
__device__ __forceinline__ float sigmoidf_(float x) { return __builtin_amdgcn_rcpf(1.f + __builtin_amdgcn_exp2f(-1.4426950408889634f * x)); }
__device__ __forceinline__ int tid_() { int t = threadIdx.x; asm volatile("" : "+v"(t)); return t; }
__device__ __forceinline__ float wave_sum(float v) {
#pragma unroll
    for (int o = 1; o < 64; o <<= 1) v += __shfl_xor(v, o);
    return v;
}

namespace pg8 {
constexpr int BM = 256, BK = 64, HALF = 128, HTB = HALF * BK * 2, STAGE_BYTES = 8 * HTB, NXCD = 8, WGM = 8;
__host__ __device__ __forceinline__ int lds_byte(int r, int c) { const int st = (r >> 4) * 2 + (c >> 5), rr = r & 15, cc = c & 31, ob = rr * 64 + cc * 2; return st * 1024 + (ob ^ (((ob >> 9) & 1) << 5)); }
__host__ __device__ __forceinline__ void stage_rc(int b, int& R, int& C) { const int st = b / 1024, sb = b % 1024, swz = sb ^ (((sb >> 9) & 1) << 5); R = (st >> 1) * 16 + swz / 64; C = (st & 1) * 32 + (swz % 64) / 2; }
__host__ __device__ __forceinline__ int perm32(int rho) { const int n = rho >> 4, i = rho & 15; return 8 * (i >> 2) + 4 * n + (i & 3); }

struct Unit { int pm, pn; };
struct Gemm { const bf16_t* A; const bf16_t* Bt; int M, N, K, lda; };

struct StaticOrder {
    int nM, nN, nwg, G, c;
    __host__ __device__ void init(int M_, int N_, int G_, int c_) { nM = M_ / BM; nN = N_ / BM; nwg = nM * nN; G = G_; c = c_; }
    __host__ __device__ bool next(int i, Unit& u) const {
        const long L = (long)i * G + c; if (L >= nwg) return false;
        int wgid = (int)L; { const int q = nwg / NXCD, r = nwg % NXCD, xcd = wgid % NXCD, off = wgid / NXCD; wgid = (xcd < r ? xcd * (q + 1) : r * (q + 1) + (xcd - r) * q) + off; }
        const int nig = WGM * nN, gid = wgid / nig, fm = gid * WGM, gsz = (nM - fm) < WGM ? (nM - fm) : WGM;
        u.pm = fm + ((wgid % nig) % gsz); u.pn = (wgid % nig) / gsz; return true;
    }
};

typedef f32x4 Acc[2][2][4][2];

struct EpiBf16R {
    static constexpr bool PERM = true;
    bf16_t* O0; int ld0; int t1; bf16_t* O1; int ld1; int t2; bf16_t* O2; int ld2;
    __device__ __forceinline__ void operator()(const Acc& acc, const Unit& u, int wr, int wc, int fr, int fq) const {
        bf16_t* base; int ldc, colt;
        if (u.pn < t1) { base = O0; ldc = ld0; colt = u.pn * BM; } else if (u.pn < t2) { base = O1; ldc = ld1; colt = (u.pn - t1) * BM; } else { base = O2; ldc = ld2; colt = (u.pn - t2) * BM; }
        const int row0 = u.pm * BM + wr * 64 + fr, col0 = colt + wc * 32 + 8 * fq;
#pragma unroll
        for (int ai = 0; ai < 2; ++ai)
#pragma unroll
            for (int m = 0; m < 4; ++m) { bf16_t* rowp = base + (size_t)(row0 + ai * HALF + m * 16) * ldc + col0;
#pragma unroll
                for (int bj = 0; bj < 2; ++bj) { const f32x4 v0 = acc[ai][bj][m][0], v1 = acc[ai][bj][m][1];
                    u32x4 w; w.x = cvt_pk_bf16(v0[0], v0[1]); w.y = cvt_pk_bf16(v0[2], v0[3]); w.z = cvt_pk_bf16(v1[0], v1[1]); w.w = cvt_pk_bf16(v1[2], v1[3]);
                    *(u32x4*)(rowp + bj * HALF) = w; } }
    }
};
struct EpiGateF32 {
    static constexpr bool PERM = false;
    float* T; const bf16_t* gate; const float* gbias; int gcol0;
    __device__ __forceinline__ void operator()(const Acc& acc, const Unit& u, int wr, int wc, int fr, int fq) const {
        const int row0 = u.pm * BM + wr * 64 + fr, col0 = u.pn * BM + wc * 32 + 4 * fq;
#pragma unroll
        for (int ai = 0; ai < 2; ++ai)
#pragma unroll
            for (int m = 0; m < 4; ++m) { const size_t row = (size_t)(row0 + ai * HALF + m * 16);
#pragma unroll
                for (int bj = 0; bj < 2; ++bj)
#pragma unroll
                    for (int n = 0; n < 2; ++n) { const int col = col0 + bj * HALF + n * 16;
                        const u32x2 gw = *(const u32x2*)(gate + row * NGATE + gcol0 + col); const f32x4 gb = *(const f32x4*)(gbias + gcol0 + col);
                        f32x4 o; o[0] = sigmoidf_(bf_lo(gw.x) + gb[0]) * acc[ai][bj][m][n][0]; o[1] = sigmoidf_(bf_hi(gw.x) + gb[1]) * acc[ai][bj][m][n][1];
                        o[2] = sigmoidf_(bf_lo(gw.y) + gb[2]) * acc[ai][bj][m][n][2]; o[3] = sigmoidf_(bf_hi(gw.y) + gb[3]) * acc[ai][bj][m][n][3];
                        *(f32x4*)(T + row * DM + col) = o; } }
    }
};
struct EpiGateAddBf16 {
    static constexpr bool PERM = true;
    bf16_t* Z; const float* T; const bf16_t* gate; const float* gbias; int gcol0;
    __device__ __forceinline__ void operator()(const Acc& acc, const Unit& u, int wr, int wc, int fr, int fq) const {
        const int row0 = u.pm * BM + wr * 64 + fr, col0 = u.pn * BM + wc * 32 + 8 * fq;
#pragma unroll
        for (int ai = 0; ai < 2; ++ai)
#pragma unroll
            for (int m = 0; m < 4; ++m) { const size_t row = (size_t)(row0 + ai * HALF + m * 16);
#pragma unroll
                for (int bj = 0; bj < 2; ++bj) { const int col = col0 + bj * HALF;
                    const u32x4 gw = *(const u32x4*)(gate + row * NGATE + gcol0 + col);
                    const f32x4 gb0 = *(const f32x4*)(gbias + gcol0 + col), gb1 = *(const f32x4*)(gbias + gcol0 + col + 4);
                    const f32x4 t0 = *(const f32x4*)(T + row * DM + col), t1 = *(const f32x4*)(T + row * DM + col + 4);
                    const f32x4 a0 = acc[ai][bj][m][0], a1 = acc[ai][bj][m][1];
                    float o[8];
                    o[0] = t0[0] + sigmoidf_(bf_lo(gw.x) + gb0[0]) * a0[0]; o[1] = t0[1] + sigmoidf_(bf_hi(gw.x) + gb0[1]) * a0[1];
                    o[2] = t0[2] + sigmoidf_(bf_lo(gw.y) + gb0[2]) * a0[2]; o[3] = t0[3] + sigmoidf_(bf_hi(gw.y) + gb0[3]) * a0[3];
                    o[4] = t1[0] + sigmoidf_(bf_lo(gw.z) + gb1[0]) * a1[0]; o[5] = t1[1] + sigmoidf_(bf_hi(gw.z) + gb1[1]) * a1[1];
                    o[6] = t1[2] + sigmoidf_(bf_lo(gw.w) + gb1[2]) * a1[2]; o[7] = t1[3] + sigmoidf_(bf_hi(gw.w) + gb1[3]) * a1[3];
                    u32x4 w; w.x = cvt_pk_bf16(o[0], o[1]); w.y = cvt_pk_bf16(o[2], o[3]); w.z = cvt_pk_bf16(o[4], o[5]); w.w = cvt_pk_bf16(o[6], o[7]);
                    *(u32x4*)(Z + row * DM + col) = w; } }
    }
};
struct EpiResF32 {
    static constexpr bool PERM = false;
    const float* base; float* out;
    __device__ __forceinline__ void operator()(const Acc& acc, const Unit& u, int wr, int wc, int fr, int fq) const {
        const int row0 = u.pm * BM + wr * 64 + fr, col0 = u.pn * BM + wc * 32 + 4 * fq;
#pragma unroll
        for (int ai = 0; ai < 2; ++ai)
#pragma unroll
            for (int m = 0; m < 4; ++m) { const size_t off = (size_t)(row0 + ai * HALF + m * 16) * DM + col0;
#pragma unroll
                for (int bj = 0; bj < 2; ++bj)
#pragma unroll
                    for (int n = 0; n < 2; ++n) { const f32x4 b = *(const f32x4*)(base + off + bj * HALF + n * 16); *(f32x4*)(out + off + bj * HALF + n * 16) = b + acc[ai][bj][m][n]; } }
    }
};

template <class Epi, class Sched, bool ALIGN_EPI = true>
__device__ __forceinline__ void gemm_phase(LAS unsigned char* lds, const Gemm g, const Sched& S, const Epi& E) {
    const int tid = tid_(), wid = __builtin_amdgcn_readfirstlane(tid >> 6), lane = tid & 63, wr = wid >> 2, wc = wid & 3, fr = lane & 15, fq = lane >> 4;
    const int K = g.K, nt = K / BK, lda = g.lda;
    unsigned voffA[2], voffB[2];
#pragma unroll
    for (int i = 0; i < 2; ++i) { int R, C; stage_rc(tid * 16 + i * 8192, R, C); const int Rb = Epi::PERM ? ((R & ~31) + perm32(R & 31)) : R;
        voffA[i] = (unsigned)(R * lda + C) * 2u; voffB[i] = (unsigned)(Rb * K + C) * 2u; }
    const size_t kstep = (size_t)(BK * 2);
    const size_t hstepA = (size_t)HALF * lda * 2, hstepB = (size_t)HALF * K * 2;
    const size_t tstepA = 2 * hstepA, tstepB = 2 * hstepB;
    const unsigned ldsw = (unsigned)wid * 1024u;
    const int aoff = lds_byte(wr * 64 + fr, fq * 8), boff = lds_byte(wc * 32 + fr, fq * 8);
#define PG8_SA(b, h) (((b) * 2 + (h)) * HTB)
#define PG8_SB(b, h) ((4 + (b) * 2 + (h)) * HTB)
#define PG8_STAGE(bufoff, gbase, voff) do { _Pragma("unroll") for (int _i = 0; _i < 2; ++_i) \
        __builtin_amdgcn_global_load_lds((const unsigned*)((const char*)(gbase) + (voff)[_i]), (LAS unsigned*)(lds + (bufoff) + ldsw + _i * 8192), 16, 0, 0); } while (0)
#define PG8_LDA(dst, b, h) do { _Pragma("unroll") for (int m = 0; m < 4; ++m) _Pragma("unroll") for (int k = 0; k < 2; ++k) dst[m][k] = *(const LAS bf16x8*)(lds + PG8_SA(b, h) + aoff + m * 2048 + k * 1024); } while (0)
#define PG8_LDB(dst, b, h) do { _Pragma("unroll") for (int n = 0; n < 2; ++n) _Pragma("unroll") for (int k = 0; k < 2; ++k) dst[n][k] = *(const LAS bf16x8*)(lds + PG8_SB(b, h) + boff + n * 2048 + k * 1024); } while (0)
#define PG8_MMA(ai, bj, At, Bt) do { __builtin_amdgcn_s_setprio(1); _Pragma("unroll") for (int m = 0; m < 4; ++m) _Pragma("unroll") for (int n = 0; n < 2; ++n) _Pragma("unroll") for (int k = 0; k < 2; ++k) \
        acc[ai][bj][m][n] = __builtin_amdgcn_mfma_f32_16x16x32_bf16(Bt[n][k], At[m][k], acc[ai][bj][m][n], 0, 0, 0); __builtin_amdgcn_s_setprio(0); } while (0)
#define PG8_WAIT_V(n) asm volatile("s_waitcnt vmcnt(" #n ")" ::: "memory")
#define PG8_WAIT_L(n) asm volatile("s_waitcnt lgkmcnt(" #n ")" ::: "memory")
#define PG8_BAR __builtin_amdgcn_s_barrier()
#define PG8_SCHED __builtin_amdgcn_sched_barrier(0)
    Unit cur, nxt; int ui = 0;
    if (!S.next(0, cur)) return;
    Acc acc;
#pragma unroll
    for (int a = 0; a < 2; ++a)
#pragma unroll
        for (int b = 0; b < 2; ++b)
#pragma unroll
            for (int m = 0; m < 4; ++m)
#pragma unroll
                for (int n = 0; n < 2; ++n) acc[a][b][m][n] = (f32x4){0.f, 0.f, 0.f, 0.f};
    bf16x8 At[4][2], B0[2][2], B1[2][2];
    const char* cA = (const char*)g.A + (size_t)cur.pm * tstepA; const char* cB = (const char*)g.Bt + (size_t)cur.pn * tstepB;
    PG8_STAGE(PG8_SB(0, 0), cB, voffB); PG8_STAGE(PG8_SB(0, 1), cB + hstepB, voffB); PG8_STAGE(PG8_SA(0, 0), cA, voffA); PG8_STAGE(PG8_SA(0, 1), cA + hstepA, voffA);
    if (wr == 1) PG8_BAR;
    PG8_WAIT_V(2); PG8_BAR;
    PG8_STAGE(PG8_SB(1, 0), cB + kstep, voffB); PG8_STAGE(PG8_SA(1, 0), cA + kstep, voffA); PG8_STAGE(PG8_SB(1, 1), cB + hstepB + kstep, voffB);
    PG8_WAIT_V(6); PG8_BAR;
    for (;;) {
        const bool has_next = S.next(ui + 1, nxt);
        const char* nA = has_next ? (const char*)g.A + (size_t)nxt.pm * tstepA : cA; const char* nB = has_next ? (const char*)g.Bt + (size_t)nxt.pn * tstepB : cB;
        for (int t = 0; t < nt; t += 2) {
            const bool last = (t == nt - 2);
            const char* a1 = cA + (size_t)(t + 1) * kstep;
            const char* a2 = last ? nA : cA + (size_t)(t + 2) * kstep; const char* b2 = last ? nB : cB + (size_t)(t + 2) * kstep;
            const char* a3 = a2 + kstep; const char* b3 = b2 + kstep;
            PG8_LDB(B0, 0, 0); PG8_LDB(B1, 0, 1); PG8_SCHED; PG8_LDA(At, 0, 0); PG8_STAGE(PG8_SA(1, 1), a1 + hstepA, voffA);
            PG8_WAIT_V(8); PG8_WAIT_L(0); PG8_BAR; PG8_MMA(0, 0, At, B0); PG8_MMA(0, 1, At, B1); PG8_BAR; PG8_SCHED;
            PG8_LDA(At, 0, 1); PG8_STAGE(PG8_SB(0, 0), b2, voffB); PG8_STAGE(PG8_SB(0, 1), b2 + hstepB, voffB); PG8_STAGE(PG8_SA(0, 0), a2, voffA);
            PG8_WAIT_V(8); PG8_WAIT_L(0); PG8_BAR; PG8_MMA(1, 0, At, B0); PG8_MMA(1, 1, At, B1); PG8_BAR; PG8_SCHED;
            PG8_LDB(B0, 1, 0); PG8_LDB(B1, 1, 1); PG8_SCHED; PG8_LDA(At, 1, 0); PG8_STAGE(PG8_SA(0, 1), a2 + hstepA, voffA);
            PG8_WAIT_V(8); PG8_WAIT_L(0); PG8_BAR; PG8_MMA(0, 0, At, B0); PG8_MMA(0, 1, At, B1); PG8_BAR; PG8_SCHED;
            PG8_LDA(At, 1, 1); PG8_STAGE(PG8_SB(1, 0), b3, voffB); PG8_STAGE(PG8_SB(1, 1), b3 + hstepB, voffB); PG8_STAGE(PG8_SA(1, 0), a3, voffA);
            PG8_WAIT_V(8); PG8_WAIT_L(0); PG8_BAR; PG8_MMA(1, 0, At, B0); PG8_MMA(1, 1, At, B1); PG8_BAR; PG8_SCHED;
        }
        if constexpr (ALIGN_EPI) { if (wr == 0) PG8_BAR; }
        E(acc, cur, wr, wc, fr, fq);
        if (!has_next) break;
#pragma unroll
        for (int a = 0; a < 2; ++a)
#pragma unroll
            for (int b = 0; b < 2; ++b)
#pragma unroll
                for (int m = 0; m < 4; ++m)
#pragma unroll
                    for (int n = 0; n < 2; ++n) acc[a][b][m][n] = (f32x4){0.f, 0.f, 0.f, 0.f};
        cur = nxt; cA = nA; cB = nB; ++ui;
        if constexpr (ALIGN_EPI) { if (wr == 1) PG8_BAR; }
    }
    PG8_WAIT_V(0);
    if constexpr (!ALIGN_EPI) { if (wr == 0) PG8_BAR; }
    PG8_BAR;
#undef PG8_SA
#undef PG8_SB
#undef PG8_STAGE
#undef PG8_LDA
#undef PG8_LDB
#undef PG8_MMA
#undef PG8_WAIT_V
#undef PG8_WAIT_L
#undef PG8_BAR
#undef PG8_SCHED
}
}

namespace att {
constexpr int NW = 8, QBLK = 32, KVBLK = 64, QB = NW * QBLK;
constexpr int SHM_V = KVBLK * 128 * 2, SHM_K = KVBLK * 128 * 2, SHM_KR = KVBLK * 64 * 2;
constexpr int OFF_V = 0, OFF_K = 2 * SHM_V, OFF_KR = OFF_K + 2 * SHM_K, OFF_WS = OFF_KR + 2 * SHM_KR, ATT_LDS_BYTES = OFF_WS + NW * 64 * 4;
constexpr float THR = 8.f;
#define KSWZ(row, colB) ((row) * 256 + ((colB) ^ (((row) & 7) << 4)))
#define KRSWZ(row, colB) ((row) * 128 + ((colB) ^ (((row) & 7) << 4)))
#define SBAR() __builtin_amdgcn_sched_barrier(0)
__device__ __forceinline__ int v_st(int k, int c) { const int kk = (k & ~0xC) | ((k & 4) << 1) | ((k & 8) >> 1); return ((kk >> 3) * 4 + (c >> 5)) * 512 + ((kk & 7) * 32 + (c & 31)) * 2; }
__device__ __forceinline__ int v_rd_base(int lane) { return ((lane & 3) << 3) | (((lane >> 2) & 3) << 6) | (((lane >> 4) & 1) << 5) | (((lane >> 5) & 1) << 8); }
constexpr int v_rd_off(int d0, int ks, int half) { return d0 * 512 + ks * 4096 + half * 2048; }
__device__ __forceinline__ int crow(int r, int hi) { return (r & 3) + 8 * (r >> 2) + 4 * hi; }
__device__ __forceinline__ unsigned cvtpk(float lo, float hi) { unsigned r; asm volatile("v_cvt_pk_bf16_f32 %0, %1, %2" : "=v"(r) : "v"(lo), "v"(hi)); return r; }

__device__ __forceinline__ void mask_tile(f32x16& p0, f32x16& p1, int dq) {
    const float NEG = -__builtin_inff();
#pragma unroll
    for (int r = 0; r < 16; ++r) {
        const int c = (r & 3) + 8 * (r >> 2);
        if (dq - c < 0) p0[r] = NEG;
        if (dq - c - 32 < 0) p1[r] = NEG;
    }
}
template <int SCALE_NUM>
__device__ __forceinline__ void partialSM(f32x16& p0, f32x16& p1, float& m_reg, float& mn, float& alpha) {
    constexpr float SCALE = SCALE_NUM == 192 ? 0.07216878364870322f : 0.08838834764831845f;
    float pmax = p0[0];
#pragma unroll
    for (int r = 1; r < 16; ++r) pmax = fmaxf(pmax, p0[r]);
#pragma unroll
    for (int r = 0; r < 16; ++r) pmax = fmaxf(pmax, p1[r]);
    { auto rr = __builtin_amdgcn_permlane32_swap(__float_as_uint(pmax), __float_as_uint(pmax), false, false);
      pmax = fmaxf(__uint_as_float(rr[0]), __uint_as_float(rr[1])); }
    constexpr float C2 = 1.4426950408889634f * SCALE;
    if (__builtin_expect(__all((pmax - m_reg) * SCALE <= THR), 1)) { mn = m_reg; alpha = 1.f; }
    else { mn = fmaxf(m_reg, pmax); alpha = __builtin_amdgcn_exp2f((m_reg - mn) * C2); m_reg = mn; }
    const float mnL = -mn * C2;
#pragma unroll
    for (int r = 0; r < 16; ++r) p0[r] = fmaf(p0[r], C2, mnL);
#pragma unroll
    for (int r = 0; r < 16; ++r) p1[r] = fmaf(p1[r], C2, mnL);
#pragma unroll
    for (int r = 0; r < 16; ++r) p0[r] = __builtin_amdgcn_exp2f(p0[r]);
}
__device__ __forceinline__ void finishSM(f32x16& p0, f32x16& p1, float alpha, float& l_reg, bf16x8& pa0, bf16x8& pa1, bf16x8& pa2, bf16x8& pa3) {
#pragma unroll
    for (int r = 0; r < 16; ++r) p1[r] = __builtin_amdgcn_exp2f(p1[r]);
    float ps = 0;
#pragma unroll
    for (int r = 0; r < 16; ++r) ps += p0[r];
#pragma unroll
    for (int r = 0; r < 16; ++r) ps += p1[r];
    { auto rr = __builtin_amdgcn_permlane32_swap(__float_as_uint(ps), __float_as_uint(ps), false, false);
      ps = __uint_as_float(rr[0]) + __uint_as_float(rr[1]); }
    l_reg = l_reg * alpha + ps;
#define PK4(P, B_, OUT) do { unsigned a0 = cvtpk(P[B_+0], P[B_+1]), a1 = cvtpk(P[B_+2], P[B_+3]);                          \
        unsigned b0 = cvtpk(P[B_+4], P[B_+5]), b1 = cvtpk(P[B_+6], P[B_+7]);                                             \
        auto r0 = __builtin_amdgcn_permlane32_swap(a0, b0, false, false); auto r1 = __builtin_amdgcn_permlane32_swap(a1, b1, false, false); \
        u32x4 w = {r0[0], r1[0], r0[1], r1[1]}; OUT = *reinterpret_cast<bf16x8*>(&w); } while (0)
    PK4(p0, 0, pa0); PK4(p0, 8, pa1); PK4(p1, 0, pa2); PK4(p1, 8, pa3);
#undef PK4
}
template <int KB, bool ROPE>
__device__ __forceinline__ void qkt(f32x16& p0, f32x16& p1, const char* lds, int r32, int hi, const bf16x8* qr) {
    p0 = f32x16{}; p1 = f32x16{};
    const char* kb[4];
#pragma unroll
    for (int dd = 0; dd < 4; ++dd) kb[dd] = lds + OFF_K + KB * SHM_K + KSWZ(r32, (dd * 16 + hi * 8) * 2);
#pragma unroll
    for (int d0 = 0; d0 < 8; ++d0) { const char* a = kb[d0 & 3] + (d0 >> 2) * 128;
        bf16x8 b0 = *reinterpret_cast<const bf16x8*>(a);
        bf16x8 b1 = *reinterpret_cast<const bf16x8*>(a + 32 * 256);
        p0 = __builtin_amdgcn_mfma_f32_32x32x16_bf16(b0, qr[d0], p0, 0, 0, 0);
        p1 = __builtin_amdgcn_mfma_f32_32x32x16_bf16(b1, qr[d0], p1, 0, 0, 0); }
    if constexpr (ROPE) {
#pragma unroll
        for (int dd = 0; dd < 4; ++dd) { const char* a = lds + OFF_KR + KB * SHM_KR + KRSWZ(r32, (dd * 16 + hi * 8) * 2);
            bf16x8 b0 = *reinterpret_cast<const bf16x8*>(a);
            bf16x8 b1 = *reinterpret_cast<const bf16x8*>(a + 32 * 128);
            p0 = __builtin_amdgcn_mfma_f32_32x32x16_bf16(b0, qr[8 + dd], p0, 0, 0, 0);
            p1 = __builtin_amdgcn_mfma_f32_32x32x16_bf16(b1, qr[8 + dd], p1, 0, 0, 0); }
    }
}
template <int VB>
__device__ __forceinline__ void pv_tile(f32x16* o, int vb0, bf16x8 pa0, bf16x8 pa1, bf16x8 pa2, bf16x8 pa3) {
#define TRRD(dst, off) asm volatile("ds_read_b64_tr_b16 %0, %1 offset:%2" : "=&v"(dst) : "v"(vb0), "i"(off) : "memory")
#define PV_D0(d0) do { s16x4 l0, l1, l2, l3, h0, h1, h2, h3; constexpr int b_ = OFF_V + VB * SHM_V + v_rd_off(d0, 0, 0);  \
        TRRD(l0, b_); TRRD(h0, b_ + 2048); TRRD(l1, b_ + 4096); TRRD(h1, b_ + 6144); TRRD(l2, b_ + 8192); TRRD(h2, b_ + 10240); TRRD(l3, b_ + 12288); TRRD(h3, b_ + 14336); \
        asm volatile("s_waitcnt lgkmcnt(0)" ::: "memory"); SBAR();   \
        o[d0] = __builtin_amdgcn_mfma_f32_32x32x16_bf16(pa0, (bf16x8){l0[0], l0[1], l0[2], l0[3], h0[0], h0[1], h0[2], h0[3]}, o[d0], 0, 0, 0);   \
        o[d0] = __builtin_amdgcn_mfma_f32_32x32x16_bf16(pa1, (bf16x8){l1[0], l1[1], l1[2], l1[3], h1[0], h1[1], h1[2], h1[3]}, o[d0], 0, 0, 0);   \
        o[d0] = __builtin_amdgcn_mfma_f32_32x32x16_bf16(pa2, (bf16x8){l2[0], l2[1], l2[2], l2[3], h2[0], h2[1], h2[2], h2[3]}, o[d0], 0, 0, 0);   \
        o[d0] = __builtin_amdgcn_mfma_f32_32x32x16_bf16(pa3, (bf16x8){l3[0], l3[1], l3[2], l3[3], h3[0], h3[1], h3[2], h3[3]}, o[d0], 0, 0, 0); } while (0)
    PV_D0(0); PV_D0(1); PV_D0(2); PV_D0(3);
#undef PV_D0
#undef TRRD
}

struct Head {
    const bf16_t* Q; const bf16_t* K; const bf16_t* KR; const bf16_t* V; bf16_t* O;
    const float* cosT; const float* sinT;
    const bf16_t* KM;
};
struct Stage { bf16x8 k0, k1, v0, v1, kr; };

template <bool MOBA>
__device__ __forceinline__ void attn_block(const Head& T, int qb, char* lds) {
    constexpr bool ROPE = !MOBA;
    constexpr int QS = MOBA ? NMOBA : NQ, KS = MOBA ? NMOBA : NKV, VS = KS, KRS = NLAT, OS = DM;
    const int tid = tid_(), wid = __builtin_amdgcn_readfirstlane(tid >> 6), lane = tid & 63, r32 = lane & 31, hi = lane >> 5;
    const int NT = (qb + 1) * 4;
    const int P0 = qb * QB, qlo = P0 + wid * QBLK, qm = qlo + r32 - 4 * hi;
    float* ws = (float*)(lds + OFF_WS) + wid * 64; float* li_l = ws, * al_l = ws + 32;
    const int sr = tid >> 4, sc = (tid & 15) * 8, vst0 = v_st(sr, sc), vst1 = v_st(32 + sr, sc), kws = KSWZ(sr, sc * 2);
    const int rr_ = tid >> 3, rc_ = (tid & 7) * 8, krws = KRSWZ(rr_, rc_ * 2);
    const int vb0 = (int)(uintptr_t)lds + v_rd_base(lane);
    bf16x8 qr[ROPE ? 12 : 8];
    { const char* qbase = (const char*)T.Q + (size_t)(P0 + wid * QBLK) * QS * 2; const unsigned qoff = (unsigned)(r32 * QS + hi * 8) * 2u;
#pragma unroll
      for (int d0 = 0; d0 < (ROPE ? 12 : 8); ++d0) qr[d0] = *reinterpret_cast<const bf16x8*>(qbase + qoff + d0 * 32);
      if constexpr (ROPE) {
          const int pos = P0 + wid * QBLK + r32;
#pragma unroll
          for (int dd = 0; dd < 2; ++dd) {
              const f32x4 c0 = *(const f32x4*)(T.cosT + (size_t)pos * 32 + dd * 16 + hi * 8), c1 = *(const f32x4*)(T.cosT + (size_t)pos * 32 + dd * 16 + hi * 8 + 4);
              const f32x4 s0 = *(const f32x4*)(T.sinT + (size_t)pos * 32 + dd * 16 + hi * 8), s1 = *(const f32x4*)(T.sinT + (size_t)pos * 32 + dd * 16 + hi * 8 + 4);
              const u32x4 x1 = __builtin_bit_cast(u32x4, qr[8 + dd]), x2 = __builtin_bit_cast(u32x4, qr[10 + dd]);
              u32x4 y1, y2;
#pragma unroll
              for (int w = 0; w < 4; ++w) {
                  const float a_lo = bf_lo(x1[w]), a_hi = bf_hi(x1[w]), b_lo = bf_lo(x2[w]), b_hi = bf_hi(x2[w]);
                  const float cl = (w < 2 ? c0 : c1)[(2 * w) & 3], ch = (w < 2 ? c0 : c1)[(2 * w + 1) & 3];
                  const float sl = (w < 2 ? s0 : s1)[(2 * w) & 3], sh = (w < 2 ? s0 : s1)[(2 * w + 1) & 3];
                  y1[w] = pk2(a_lo * cl - b_lo * sl, a_hi * ch - b_hi * sh);
                  y2[w] = pk2(a_lo * sl + b_lo * cl, a_hi * sh + b_hi * ch);
              }
              qr[8 + dd] = __builtin_bit_cast(bf16x8, y1); qr[10 + dd] = __builtin_bit_cast(bf16x8, y2);
          }
      }
    }
    int sel0 = -1, sel1 = -1, sel2 = -1;
    if constexpr (MOBA) {
        f32x16 g = f32x16{};
        const unsigned kmoff = (unsigned)(r32 * 128 + hi * 8) * 2u;
#pragma unroll
        for (int d0 = 0; d0 < 8; ++d0) { const bf16x8 a = *reinterpret_cast<const bf16x8*>((const char*)T.KM + kmoff + d0 * 32); g = __builtin_amdgcn_mfma_f32_32x32x16_bf16(a, qr[d0], g, 0, 0, 0); }
        const float NEG = -__builtin_inff();
        float v0 = NEG, v1 = NEG, v2 = NEG;
#define INS3(x, bi) do { const float x_ = (x); const int b_ = (bi);                                                     \
            const bool g0 = (x_ > v0) || (x_ == v0 && x_ > NEG && b_ < sel0), g1 = (x_ > v1) || (x_ == v1 && x_ > NEG && b_ < sel1), g2 = (x_ > v2) || (x_ == v2 && x_ > NEG && b_ < sel2); \
            if (g0) { v2 = v1; sel2 = sel1; v1 = v0; sel1 = sel0; v0 = x_; sel0 = b_; }                                      \
            else if (g1) { v2 = v1; sel2 = sel1; v1 = x_; sel1 = b_; }                                                       \
            else if (g2) { v2 = x_; sel2 = b_; } } while (0)
#pragma unroll
        for (int r = 0; r < 16; ++r) { const int blk = crow(r, hi); const float x = blk < qb ? g[r] : NEG; INS3(x, blk); }
        const float pv0 = __shfl_xor(v0, 32), pv1 = __shfl_xor(v1, 32), pv2 = __shfl_xor(v2, 32);
        const int ps0 = __shfl_xor(sel0, 32), ps1 = __shfl_xor(sel1, 32), ps2 = __shfl_xor(sel2, 32);
        INS3(pv0, ps0); INS3(pv1, ps1); INS3(pv2, ps2);
#undef INS3
    }
    float m_reg = -1e30f, l_reg = 0; f32x16 o[4] = {};
    Stage S;
    const unsigned koff0 = (unsigned)(sr * KS + sc) * 2u, koff1 = (unsigned)((32 + sr) * KS + sc) * 2u, kroff = (unsigned)(rr_ * KRS + rc_) * 2u;
#define SLOAD(kp_) do { const char* kp__ = (const char*)T.K + (size_t)(kp_) * KS * 2; const char* vp__ = (const char*)T.V + (size_t)(kp_) * VS * 2;          \
                       S.v0 = *reinterpret_cast<const bf16x8*>(vp__ + koff0); S.v1 = *reinterpret_cast<const bf16x8*>(vp__ + koff1);   \
                       S.k0 = *reinterpret_cast<const bf16x8*>(kp__ + koff0); S.k1 = *reinterpret_cast<const bf16x8*>(kp__ + koff1);   \
                       if constexpr (ROPE) S.kr = *reinterpret_cast<const bf16x8*>((const char*)T.KR + (size_t)(kp_) * KRS * 2 + kroff); } while (0)
#define SWRITE(bf) do { *(bf16x8*)(lds + OFF_K + (bf) * SHM_K + kws) = S.k0; *(bf16x8*)(lds + OFF_K + (bf) * SHM_K + kws + 32 * 256) = S.k1;       \
                        *(bf16x8*)(lds + OFF_V + (bf) * SHM_V + vst0) = S.v0; *(bf16x8*)(lds + OFF_V + (bf) * SHM_V + vst1) = S.v1;                  \
                        if constexpr (ROPE) *(bf16x8*)(lds + OFF_KR + (bf) * SHM_KR + krws) = S.kr; } while (0)
#define RESC(a) do { if (__any((a) < 1.f)) { if (hi == 0) al_l[r32] = (a); asm volatile("s_waitcnt lgkmcnt(0)" ::: "memory");              \
                     _Pragma("unroll") for (int d_ = 0; d_ < 4; ++d_) _Pragma("unroll") for (int r = 0; r < 16; ++r) o[d_][r] *= al_l[crow(r, hi)]; } } while (0)
#define STEP(t, BF) do {                                                                                                     \
        const int kb_ = (t) * KVBLK; const bool more_ = (t) + 1 < NT;                                                        \
        if (more_) SLOAD(kb_ + KVBLK);                                                                                       \
        bool act_; bool keep_ = true;                                                                                        \
        if constexpr (MOBA) { const int j_ = (t) >> 2; if (j_ < qb) { keep_ = (j_ == sel0) || (j_ == sel1) || (j_ == sel2); act_ = __any(keep_); } else { act_ = kb_ <= qlo + QBLK - 1; } } \
        else { act_ = kb_ <= qlo + QBLK - 1; }                                                                               \
        if (act_) {                                                                                                          \
            f32x16 p0, p1; float mn, al; bf16x8 pa0, pa1, pa2, pa3;                                                          \
            SBAR(); qkt<BF, ROPE>(p0, p1, lds, r32, hi, qr); SBAR();                                                         \
            if (MOBA && ((t) >> 2) < qb) { if (!keep_) { const float NEG_ = -__builtin_inff(); _Pragma("unroll") for (int r = 0; r < 16; ++r) { p0[r] = NEG_; p1[r] = NEG_; } } } \
            else if (kb_ + KVBLK - 1 > qlo) mask_tile(p0, p1, qm - kb_);                                                     \
            partialSM<MOBA ? 128 : 192>(p0, p1, m_reg, mn, al);                                                              \
            RESC(al);                                                                                                        \
            finishSM(p0, p1, al, l_reg, pa0, pa1, pa2, pa3); SBAR();                                                         \
            pv_tile<BF>(o, vb0, pa0, pa1, pa2, pa3); SBAR();                                                                 \
        }                                                                                                                    \
        if (more_) { VM_WAIT(); SWRITE((BF) ^ 1); }                                                                          \
        __syncthreads(); } while (0)
    SLOAD(0); VM_WAIT(); SWRITE(0); __syncthreads();
    for (int t = 0; t < NT; t += 2) { STEP(t, 0); STEP(t + 1, 1); }
    if (hi == 0) li_l[r32] = l_reg; asm volatile("s_waitcnt lgkmcnt(0)" ::: "memory");
    float rli[16];
#pragma unroll
    for (int r = 0; r < 16; ++r) rli[r] = __builtin_amdgcn_rcpf(li_l[crow(r, hi)]);
    char* Ow = (char*)T.O + (size_t)(P0 + wid * QBLK) * OS * 2; const unsigned ooff = (unsigned)(4 * hi * OS + r32) * 2u;
#pragma unroll
    for (int r = 0; r < 16; ++r) { const int orow0 = (r & 3) + 8 * (r >> 2);
#pragma unroll
        for (int d0 = 0; d0 < 4; ++d0) { const float v = o[d0][r] * rli[r];
            const float vn = __shfl_xor(v, 1);
            if ((r32 & 1) == 0) *(unsigned*)(Ow + ooff + (orow0 * OS + d0 * 32) * 2) = cvtpk(v, vn); } }
    __syncthreads();
#undef SLOAD
#undef SWRITE
#undef RESC
#undef STEP
}

constexpr int MB_OACC = 65536, MB_OSTRIDE = 272;
constexpr int MB_ST = MB_OACC + 256 * MB_OSTRIDE;
constexpr int MB_CNT = MB_ST + 2048;
constexpr int MB_BL = MB_CNT + 128;
constexpr int MB_LIST = MB_BL + 512;
constexpr int MB_END = MB_LIST + 32 * 256;
static_assert(MB_END <= ::LDS_BYTES - 1024, "moba lds");
template <int VB>
__device__ __forceinline__ void pv_tileT(f32x16* o, int vb0, bf16x8 pa0, bf16x8 pa1, bf16x8 pa2, bf16x8 pa3) {
#define TRRD(dst, off) asm volatile("ds_read_b64_tr_b16 %0, %1 offset:%2" : "=&v"(dst) : "v"(vb0), "i"(off) : "memory")
#define PV_D0(d0) do { s16x4 l0, l1, l2, l3, h0, h1, h2, h3; constexpr int b_ = OFF_V + VB * SHM_V + v_rd_off(d0, 0, 0);  \
        TRRD(l0, b_); TRRD(h0, b_ + 2048); TRRD(l1, b_ + 4096); TRRD(h1, b_ + 6144); TRRD(l2, b_ + 8192); TRRD(h2, b_ + 10240); TRRD(l3, b_ + 12288); TRRD(h3, b_ + 14336); \
        asm volatile("s_waitcnt lgkmcnt(0)" ::: "memory"); SBAR();   \
        o[d0] = __builtin_amdgcn_mfma_f32_32x32x16_bf16((bf16x8){l0[0], l0[1], l0[2], l0[3], h0[0], h0[1], h0[2], h0[3]}, pa0, o[d0], 0, 0, 0);   \
        o[d0] = __builtin_amdgcn_mfma_f32_32x32x16_bf16((bf16x8){l1[0], l1[1], l1[2], l1[3], h1[0], h1[1], h1[2], h1[3]}, pa1, o[d0], 0, 0, 0);   \
        o[d0] = __builtin_amdgcn_mfma_f32_32x32x16_bf16((bf16x8){l2[0], l2[1], l2[2], l2[3], h2[0], h2[1], h2[2], h2[3]}, pa2, o[d0], 0, 0, 0);   \
        o[d0] = __builtin_amdgcn_mfma_f32_32x32x16_bf16((bf16x8){l3[0], l3[1], l3[2], l3[3], h3[0], h3[1], h3[2], h3[3]}, pa3, o[d0], 0, 0, 0); } while (0)
    PV_D0(0); PV_D0(1); PV_D0(2); PV_D0(3);
#undef PV_D0
#undef TRRD
}
__device__ __forceinline__ void moba_block(const Head& T, int qb, char* lds) {
    constexpr int QS = NMOBA, KS = NMOBA, VS = NMOBA, OS = DM;
    constexpr float C2 = 1.4426950408889634f * 0.08838834764831845f;
    const int tid = tid_(), wid = __builtin_amdgcn_readfirstlane(tid >> 6), lane = tid & 63, r32 = lane & 31, hi = lane >> 5;
    const int P0 = qb * QB;
    int* cnt = (int*)(lds + MB_CNT); int* bl = (int*)(lds + MB_BL); unsigned char* list = (unsigned char*)(lds + MB_LIST);
    float* st = (float*)(lds + MB_ST);
    if (tid < 32) cnt[tid] = 0;
    if (tid < 256) { st[2 * tid] = -1e30f; st[2 * tid + 1] = 0.f; }
    __syncthreads();
    const char* qbase = (const char*)T.Q + (size_t)P0 * QS * 2;
    {
        bf16x8 qg[8];
        { const unsigned qoff = (unsigned)((wid * QBLK + r32) * QS + hi * 8) * 2u;
#pragma unroll
          for (int d0 = 0; d0 < 8; ++d0) qg[d0] = *reinterpret_cast<const bf16x8*>(qbase + qoff + d0 * 32); }
        int sel0 = -1, sel1 = -1, sel2 = -1;
        f32x16 g = f32x16{};
        const unsigned kmoff = (unsigned)(r32 * 128 + hi * 8) * 2u;
#pragma unroll
        for (int d0 = 0; d0 < 8; ++d0) { const bf16x8 a = *reinterpret_cast<const bf16x8*>((const char*)T.KM + kmoff + d0 * 32); g = __builtin_amdgcn_mfma_f32_32x32x16_bf16(a, qg[d0], g, 0, 0, 0); }
        const float NEG = -__builtin_inff();
        float v0 = NEG, v1 = NEG, v2 = NEG;
#define INS3(x, bi) do { const float x_ = (x); const int b_ = (bi);                                                     \
            const bool g0 = (x_ > v0) || (x_ == v0 && x_ > NEG && b_ < sel0), g1 = (x_ > v1) || (x_ == v1 && x_ > NEG && b_ < sel1), g2 = (x_ > v2) || (x_ == v2 && x_ > NEG && b_ < sel2); \
            if (g0) { v2 = v1; sel2 = sel1; v1 = v0; sel1 = sel0; v0 = x_; sel0 = b_; }                                      \
            else if (g1) { v2 = v1; sel2 = sel1; v1 = x_; sel1 = b_; }                                                       \
            else if (g2) { v2 = x_; sel2 = b_; } } while (0)
#pragma unroll
        for (int r = 0; r < 16; ++r) { const int blk = crow(r, hi); const float x = blk < qb ? g[r] : NEG; INS3(x, blk); }
        const float pv0 = __shfl_xor(v0, 32), pv1 = __shfl_xor(v1, 32), pv2 = __shfl_xor(v2, 32);
        const int ps0 = __shfl_xor(sel0, 32), ps1 = __shfl_xor(sel1, 32), ps2 = __shfl_xor(sel2, 32);
        INS3(pv0, ps0); INS3(pv1, ps1); INS3(pv2, ps2);
#undef INS3
        if (hi == 0) { const unsigned char row = (unsigned char)(wid * QBLK + r32);
            if (sel0 >= 0) { const int p = atomicAdd(cnt + sel0, 1); list[sel0 * 256 + p] = row; }
            if (sel1 >= 0) { const int p = atomicAdd(cnt + sel1, 1); list[sel1 * 256 + p] = row; }
            if (sel2 >= 0) { const int p = atomicAdd(cnt + sel2, 1); list[sel2 * 256 + p] = row; } }
    }
    __syncthreads();
    if (tid == 0) { int nr = 0; for (int j = 0; j < qb; ++j) { const int c = cnt[j]; if (c > 0) bl[nr++] = j; if (c > 128) bl[nr++] = j | 256; } bl[nr] = qb; bl[nr + 1] = qb | 256; bl[80] = nr; }
    __syncthreads();
    const int nr = __builtin_amdgcn_readfirstlane(bl[80]);
    const int NR = nr + 2, NT = 4 * NR;
#define KB_OF(t) ((__builtin_amdgcn_readfirstlane(bl[(t) >> 2]) & 255) * 256 + ((t) & 3) * KVBLK)
    if (wid >= 4) {
        const int lt = tid - 256;
        bf16x8 S0[8], S1[8], S2[8], S3[8];
        unsigned srck[4], dstk[4], dstv[4];
#pragma unroll
        for (int i = 0; i < 4; ++i) { const int c = lt + 256 * i, rw = c >> 4, cc = c & 15; srck[i] = (unsigned)(rw * KS + cc * 8) * 2u; dstk[i] = (unsigned)KSWZ(rw, cc * 16); dstv[i] = (unsigned)v_st(rw, cc * 8); }
#define LLOAD(SET, t) do { const int tt_ = (t) < NT ? (t) : NT - 1; const int kb_ = KB_OF(tt_);                             \
            const char* kp__ = (const char*)T.K + (size_t)kb_ * KS * 2; const char* vp__ = (const char*)T.V + (size_t)kb_ * VS * 2;   \
            _Pragma("unroll") for (int i = 0; i < 4; ++i) { SET[i] = *reinterpret_cast<const bf16x8*>(kp__ + srck[i]); SET[4 + i] = *reinterpret_cast<const bf16x8*>(vp__ + srck[i]); } } while (0)
#define LWRITE(SET, bf) do { _Pragma("unroll") for (int i = 0; i < 4; ++i) { *(bf16x8*)(lds + OFF_K + (bf) * SHM_K + dstk[i]) = SET[i]; *(bf16x8*)(lds + OFF_V + (bf) * SHM_V + dstv[i]) = SET[4 + i]; } } while (0)
        LLOAD(S0, 0); LLOAD(S1, 1); LLOAD(S2, 2); LLOAD(S3, 3);
        LWRITE(S0, 0); LLOAD(S0, 4);
        __syncthreads();
#pragma unroll 1
        for (int rnd = 0; rnd < NR; ++rnd) {
            const int t = 4 * rnd;
            LWRITE(S1, 1); LLOAD(S1, t + 5); __syncthreads();
            LWRITE(S2, 0); LLOAD(S2, t + 6); __syncthreads();
            LWRITE(S3, 1); LLOAD(S3, t + 7); __syncthreads();
            LWRITE(S0, 0); LLOAD(S0, t + 8); __syncthreads();
        }
#undef LLOAD
#undef LWRITE
    } else {
        const int vb0 = (int)(uintptr_t)lds + v_rd_base(lane);
#define ROUND_ROWS(rnd, rowv, validv, actv) do { const int e_ = __builtin_amdgcn_readfirstlane(bl[rnd]); const int j_ = e_ & 255, g_ = e_ >> 8;     \
            if ((rnd) >= nr) { rowv = 128 * g_ + wid * QBLK + r32; validv = true; actv = true; }                                 \
            else { const int c_ = __builtin_amdgcn_readfirstlane(cnt[j_]); const int tb_ = 4 * g_ + ((wid - j_) & 3);             \
                   actv = tb_ * 32 < c_; const int p_ = tb_ * 32 + r32; validv = p_ < c_; rowv = validv ? (int)list[j_ * 256 + p_] : 0; } } while (0)
        float m_reg = -1e30f, l_reg = 0.f; f32x16 o[4]; bf16x8 qr[8], qn[8];
        int row = 0; bool valid = false, act = false;
        int qlo = 0;
#define STEP(t, BF, OWN) do {                                                                                                \
            const int kb_ = P0 + ((t) & 3) * KVBLK;                                                      \
            bool act_ = act; if (OWN) act_ = kb_ <= qlo + QBLK - 1;                                                           \
            if (act_) {                                                                                                      \
                f32x16 p0, p1; float mn, al; bf16x8 pa0, pa1, pa2, pa3;                                                      \
                SBAR(); qkt<BF, false>(p0, p1, lds, r32, hi, qr); SBAR();                                                    \
                if (OWN) { if (kb_ + KVBLK - 1 > qlo) mask_tile(p0, p1, qlo + r32 - 4 * hi - kb_); }                          \
                partialSM<128>(p0, p1, m_reg, mn, al);                                                                       \
                if (__any(al < 1.f)) { _Pragma("unroll") for (int d_ = 0; d_ < 4; ++d_) o[d_] = o[d_] * al; }                 \
                finishSM(p0, p1, al, l_reg, pa0, pa1, pa2, pa3); SBAR();                                                     \
                pv_tileT<BF>(o, vb0, pa0, pa1, pa2, pa3); SBAR();                                                            \
            }                                                                                                                \
            __syncthreads(); } while (0)
#define MERGE(FINAL) do { if (valid) {                                                                                       \
            const float M_ = st[2 * row], W_ = st[2 * row + 1];                                                              \
            const float Mn = fmaxf(M_, m_reg), ea = __builtin_amdgcn_exp2f((M_ - Mn) * C2), eb = __builtin_amdgcn_exp2f((m_reg - Mn) * C2);   \
            const float a_ = ea * W_, b_ = eb * l_reg, Wn = a_ + b_, inv = __builtin_amdgcn_rcpf(Wn);                        \
            const float ca = W_ > 0.f ? a_ * inv : 0.f, cb = eb * inv;                                                       \
            char* orow = lds + MB_OACC + row * MB_OSTRIDE + hi * 8;                                                          \
            char* grow = (char*)T.O + (size_t)(P0 + row) * OS * 2 + hi * 8;                                                  \
            _Pragma("unroll") for (int d0 = 0; d0 < 4; ++d0) _Pragma("unroll") for (int g_ = 0; g_ < 4; ++g_) {              \
                u32x2 old = {0u, 0u}; if (W_ > 0.f) old = *(const u32x2*)(orow + (d0 * 32 + g_ * 8) * 2);                    \
                const float n0 = ca * bf_lo(old.x) + cb * o[d0][4 * g_ + 0], n1 = ca * bf_hi(old.x) + cb * o[d0][4 * g_ + 1]; \
                const float n2 = ca * bf_lo(old.y) + cb * o[d0][4 * g_ + 2], n3 = ca * bf_hi(old.y) + cb * o[d0][4 * g_ + 3]; \
                u32x2 nw; nw.x = cvtpk(n0, n1); nw.y = cvtpk(n2, n3);                                                        \
                if (FINAL) *(u32x2*)(grow + (d0 * 32 + g_ * 8) * 2) = nw; else *(u32x2*)(orow + (d0 * 32 + g_ * 8) * 2) = nw; } \
            asm volatile("s_waitcnt lgkmcnt(0)" ::: "memory");              \
            if (!(FINAL) && hi == 0) { st[2 * row] = Mn; st[2 * row + 1] = Wn; } } } while (0)
        int rown; bool validn, actn; ROUND_ROWS(0, rown, validn, actn);
        { const unsigned qoff = (unsigned)(rown * QS + hi * 8) * 2u;
#pragma unroll
          for (int d0 = 0; d0 < 8; ++d0) qn[d0] = *reinterpret_cast<const bf16x8*>(qbase + qoff + d0 * 32); }
        __syncthreads();
#pragma unroll 1
        for (int rnd = 0; rnd < NR; ++rnd) {
            const int t = 4 * rnd;
            row = rown; valid = validn; act = actn;
#pragma unroll
            for (int d0 = 0; d0 < 8; ++d0) qr[d0] = qn[d0];
            m_reg = -1e30f; l_reg = 0.f;
#pragma unroll
            for (int d_ = 0; d_ < 4; ++d_) o[d_] = f32x16{};
            if (rnd + 1 < NR) { ROUND_ROWS(rnd + 1, rown, validn, actn);
                const unsigned qoff = (unsigned)(rown * QS + hi * 8) * 2u;
#pragma unroll
                for (int d0 = 0; d0 < 8; ++d0) qn[d0] = *reinterpret_cast<const bf16x8*>(qbase + qoff + d0 * 32); }
            if (rnd < nr) { STEP(t, 0, false); STEP(t + 1, 1, false); STEP(t + 2, 0, false); STEP(t + 3, 1, false); if (act) MERGE(false); }
            else { qlo = P0 + 128 * (rnd - nr) + wid * QBLK; STEP(t, 0, true); STEP(t + 1, 1, true); STEP(t + 2, 0, true); STEP(t + 3, 1, true); MERGE(true); }
        }
#undef ROUND_ROWS
#undef STEP
#undef MERGE
    }
#undef KB_OF
    __syncthreads();
}
#undef KSWZ
#undef KRSWZ
#undef SBAR
}

typedef GAS unsigned gu32;
#define XB_TMO      128
#define XB_XCNT(j)  (256  + 64 * (j))
#define XB_XSUB(j)  (1280 + 64 * (j))
#define XB_XGEN(j)  (2304 + 64 * (j))
#define XB_TOP      3328
#define XB_TOPGEN   3392
#define XCD_BAR_WORDS 3456
#define XB_SPIN_CAP (1u << 18)
__device__ __forceinline__ unsigned xb_ld(unsigned* p)              { return __hip_atomic_load(p, __ATOMIC_RELAXED, __HIP_MEMORY_SCOPE_AGENT); }
__device__ __forceinline__ unsigned xb_add(unsigned* p, unsigned v) { return __hip_atomic_fetch_add(p, v, __ATOMIC_RELAXED, __HIP_MEMORY_SCOPE_AGENT); }
__device__ __forceinline__ unsigned xb_xcc_id() { return (unsigned)__builtin_amdgcn_s_getreg((3 << 11) | 20) & 0xFu; }
#define XB_SPIN(cond, bar) do { unsigned _sp = 0; while (cond) { __builtin_amdgcn_s_sleep(1); \
    if ((++_sp & 255u) == 0u) { if (xb_ld(&(bar)[XB_TMO])) break; if (_sp > XB_SPIN_CAP) { atomicAdd(&(bar)[XB_TMO], 1u); break; } } } } while (0)
struct XcdBarrier { unsigned* bar; unsigned x; volatile LAS unsigned* st; };
__device__ __forceinline__ XcdBarrier xcd_barrier_post(unsigned* bar, volatile LAS unsigned* st) {
    XcdBarrier b; b.bar = bar; b.x = xb_xcc_id(); b.st = st;
    if (threadIdx.x == 0) (void)xb_add(&bar[XB_XCNT(b.x)], 1u);
    return b;
}
__device__ __forceinline__ void xcd_barrier_complete(unsigned* bar, unsigned x, unsigned& nloc, unsigned& nx) {
    const unsigned G = gridDim.x * gridDim.y * gridDim.z;
    unsigned sum, cnt, mine, sp = 0u;
    for (;;) {
        sum = 0u; cnt = 0u; mine = 0u;
#pragma unroll
        for (unsigned j = 0; j < 16; ++j) { const unsigned c = xb_ld(&bar[XB_XCNT(j)]); sum += c; cnt += (c > 0u) ? 1u : 0u; mine = (j == x) ? c : mine; }
        if (sum == G) break;
        __builtin_amdgcn_s_sleep(1);
        if ((++sp & 255u) == 0u) { if (xb_ld(&bar[XB_TMO])) break; if (sp > XB_SPIN_CAP) { atomicAdd(&bar[XB_TMO], 1u); break; } }
    }
    nloc = mine > 0u ? mine : 1u; nx = cnt > 0u ? cnt : 1u;
}
__device__ __forceinline__ void xcd_barrier(const XcdBarrier& b) {
    asm volatile("s_waitcnt vmcnt(0)" ::: "memory");
    __syncthreads();
    if (threadIdx.x == 0) {
        unsigned* bar = b.bar;
        __builtin_amdgcn_s_waitcnt(0);
        unsigned nloc = b.st[0], nx = b.st[1];
        if (nloc == 0u) { xcd_barrier_complete(bar, b.x, nloc, nx); b.st[0] = nloc; b.st[1] = nx; }
        const unsigned old = xb_add(&bar[XB_XSUB(b.x)], 1u);
        const unsigned gen = old / nloc;
        if (old + 1u == (gen + 1u) * nloc) {
            __builtin_amdgcn_fence(__ATOMIC_RELEASE, "agent");
            asm volatile("s_waitcnt vmcnt(0)" ::: "memory");
            const unsigned og = xb_add(&bar[XB_TOP], 1u);
            const unsigned tg = og / nx;
            if (og + 1u == (tg + 1u) * nx) xb_add(&bar[XB_TOPGEN], 1u);
            else XB_SPIN(xb_ld(&bar[XB_TOPGEN]) == tg, bar);
            __builtin_amdgcn_fence(__ATOMIC_ACQUIRE, "agent");
            xb_add(&bar[XB_XGEN(b.x)], 1u);
            asm volatile("s_waitcnt vmcnt(0)" ::: "memory");
        } else {
            XB_SPIN(xb_ld(&bar[XB_XGEN(b.x)]) == gen, bar);
            __builtin_amdgcn_fence(__ATOMIC_ACQUIRE, "agent");
            asm volatile("s_waitcnt vmcnt(0)" ::: "memory");
        }
    }
    __syncthreads();
}

struct Frame {
    LAS unsigned char* lds;
    volatile LAS unsigned* MISC;
    gu32* ctl;
    int vcu, G;
    unsigned char* ws;
    float* out;
};
__device__ __forceinline__ const float* ldp(const Frame& F, int k) {
    volatile LAS unsigned* p = F.MISC + 32 + 2 * k; unsigned lo = p[0], hi = p[1];
    lo = __builtin_amdgcn_readfirstlane(lo); hi = __builtin_amdgcn_readfirstlane(hi);
    return (const float*)(const GAS float*)(((unsigned long long)hi << 32) | (unsigned long long)lo);
}
__device__ __forceinline__ void unpack8(const u32x4 w, float* f) {
    f[0] = bf_lo(w.x); f[1] = bf_hi(w.x); f[2] = bf_lo(w.y); f[3] = bf_hi(w.y); f[4] = bf_lo(w.z); f[5] = bf_hi(w.z); f[6] = bf_lo(w.w); f[7] = bf_hi(w.w);
}
__device__ __forceinline__ u32x4 pack8f(const float* f) { u32x4 w; w.x = pk2(f[0], f[1]); w.y = pk2(f[2], f[3]); w.z = pk2(f[4], f[5]); w.w = pk2(f[6], f[7]); return w; }

__device__ __forceinline__ void p0_transpose_item(const float* W, int K, int N, bf16_t* WT, int row_off, LAS float* scr, int item, int lane) {
    const int nblk = N / 32, kb = item / nblk, nb = item % nblk, k0 = 64 * kb, n0 = 32 * nb;
#pragma unroll 8
    for (int i = 0; i < 32; ++i) { const int kk = 2 * i + (lane >> 5); scr[kk * 33 + (lane & 31)] = W[(size_t)(k0 + kk) * N + n0 + (lane & 31)]; }
    LDS_WAIT(); asm volatile("" ::: "memory");
    const int c = lane & 7;
#pragma unroll
    for (int j = 0; j < 4; ++j) { const int n = (lane >> 3) + 8 * j; const LAS float* s = scr + (8 * c) * 33 + n;
        u32x4 o; o.x = pk2(s[0 * 33], s[1 * 33]); o.y = pk2(s[2 * 33], s[3 * 33]); o.z = pk2(s[4 * 33], s[5 * 33]); o.w = pk2(s[6 * 33], s[7 * 33]);
        *(GAS u32x4*)(WT + (size_t)(row_off + n0 + n) * K + k0 + 8 * c) = o; }
    LDS_WAIT(); asm volatile("" ::: "memory");
}
__device__ __forceinline__ void rms_row_to_bf16(int lane, const float* xrow, const float* g, bf16_t* orow) {
    const f32x4* xr = (const f32x4*)xrow + lane; const f32x4* gr = (const f32x4*)g + lane;
    f32x4 v[4]; float s = 0.f;
#pragma unroll
    for (int j = 0; j < 4; ++j) { v[j] = xr[64 * j]; s += (v[j].x * v[j].x + v[j].y * v[j].y) + (v[j].z * v[j].z + v[j].w * v[j].w); }
    const float rstd = 1.f / sqrtf(wave_sum(s) * (1.f / DM) + EPS);
    unsigned long long* o8 = (unsigned long long*)orow + lane;
#pragma unroll
    for (int j = 0; j < 4; ++j) { const f32x4 gg = gr[64 * j];
        o8[64 * j] = (unsigned long long)pk2(v[j].x * rstd * gg.x, v[j].y * rstd * gg.y) | ((unsigned long long)pk2(v[j].z * rstd * gg.z, v[j].w * rstd * gg.w) << 32); }
}
__device__ __forceinline__ void rms_row_f32(int lane, const float* xrow, const float* g, float* orow) {
    const f32x4* xr = (const f32x4*)xrow + lane; const f32x4* gr = (const f32x4*)g + lane;
    f32x4 v[4]; float s = 0.f;
#pragma unroll
    for (int j = 0; j < 4; ++j) { v[j] = xr[64 * j]; s += (v[j].x * v[j].x + v[j].y * v[j].y) + (v[j].z * v[j].z + v[j].w * v[j].w); }
    const float rstd = 1.f / sqrtf(wave_sum(s) * (1.f / DM) + EPS);
    f32x4* o = (f32x4*)orow + lane;
#pragma unroll
    for (int j = 0; j < 4; ++j) o[64 * j] = v[j] * rstd * gr[64 * j];
}

__device__ __forceinline__ void p0_prologue(Frame& F) {
    const int tid = tid_(), lane = tid & 63, wave = __builtin_amdgcn_readfirstlane(tid >> 6);
    LAS float* scr = (LAS float*)(F.lds + wave * 16384);
    const int gw = F.vcu * NWAVES + wave, NGW = F.G * NWAVES;
    const float* w_in = ldp(F, 2); const float* w_uq = ldp(F, 5); const float* w_ukv = ldp(F, 7); const float* w_oa = ldp(F, 8); const float* w_ob = ldp(F, 9);
    const float* w_out = ldp(F, 10); const float* w_up = ldp(F, 12); const float* w_dn = ldp(F, 15);
    bf16_t* Win = (bf16_t*)(F.ws + WS_WIN); bf16_t* Wuq = (bf16_t*)(F.ws + WS_WUQ); bf16_t* Wukv = (bf16_t*)(F.ws + WS_WUKV); bf16_t* Woa = (bf16_t*)(F.ws + WS_WOA);
    bf16_t* Wob = (bf16_t*)(F.ws + WS_WOB); bf16_t* Wout = (bf16_t*)(F.ws + WS_WOUT); bf16_t* Wup = (bf16_t*)(F.ws + WS_WUP); bf16_t* Wdn = (bf16_t*)(F.ws + WS_WDN);
    constexpr int NIN0 = 5824;
    constexpr int I_IN = (DM / 64) * (NIN0 / 32), I_UQ = (QL / 64) * (NQ / 32), I_UKV = (KVL / 64) * (NKV / 32), I_O = (DM / 64) * (DM / 32), I_UP = (DM / 64) * (NUP / 32), I_DN = (DFF / 64) * (DM / 32);
    constexpr int NITEMS = I_IN + I_UQ + I_UKV + 3 * I_O + I_UP + I_DN;
    for (int it = gw; it < NITEMS; it += NGW) {
        int r = it;
        if (r < I_IN) { const int nb = r % (NIN0 / 32); p0_transpose_item(w_in, DM, NIN0, Win, (nb * 32 >= 704) ? 64 : 0, scr, r, lane); continue; } r -= I_IN;
        if (r < I_UQ) { p0_transpose_item(w_uq, QL, NQ, Wuq, 0, scr, r, lane); continue; } r -= I_UQ;
        if (r < I_UKV) { p0_transpose_item(w_ukv, KVL, NKV, Wukv, 0, scr, r, lane); continue; } r -= I_UKV;
        if (r < I_O) { p0_transpose_item(w_oa, DM, DM, Woa, 0, scr, r, lane); continue; } r -= I_O;
        if (r < I_O) { p0_transpose_item(w_ob, DM, DM, Wob, 0, scr, r, lane); continue; } r -= I_O;
        if (r < I_O) { p0_transpose_item(w_out, DM, DM, Wout, 0, scr, r, lane); continue; } r -= I_O;
        if (r < I_UP) { p0_transpose_item(w_up, DM, NUP, Wup, 0, scr, r, lane); continue; } r -= I_UP;
        p0_transpose_item(w_dn, DFF, DM, Wdn, 0, scr, r, lane);
    }
    const int gt = F.vcu * (NWAVES * 64) + tid, NGT = F.G * NWAVES * 64;
    for (int i = gt; i < 64 * DM / 8; i += NGT) *(GAS u32x4*)(Win + (size_t)704 * DM + (size_t)i * 8) = (u32x4){0u, 0u, 0u, 0u};
    float* csb = (float*)(F.ws + WS_CSB); float* csa = (float*)(F.ws + WS_CSA);
    for (int i = gt; i < SEQ * 64; i += NGT) { const int pos = i >> 6, k = i & 63; const float inv = powf(10000.0f, -(float)k / 64.0f); const float ang = (float)pos * inv;
        csb[i] = cosf(ang); csb[SEQ * 64 + i] = sinf(ang); }
    for (int i = gt; i < SEQ * 32; i += NGT) { const int pos = i >> 5, k = i & 31; const float inv = powf(10000.0f, -(float)k / 32.0f); const float ang = (float)pos * inv;
        csa[i] = cosf(ang); csa[SEQ * 32 + i] = sinf(ang); }
    bf16_t* XN = (bf16_t*)(F.ws + WS_XN);
    { const float* x_ = ldp(F, 0); const float* g_ = ldp(F, 1);
      for (int m = gw; m < M; m += NGW) rms_row_to_bf16(lane, x_ + (size_t)m * DM, g_, XN + (size_t)m * DM); }
}

__device__ __forceinline__ void rope8(const u32x4 x1, const u32x4 x2, const float* cs, const float* sn, u32x4& y1, u32x4& y2, float* acc1, float* acc2) {
    float a[8], b[8], o1[8], o2[8]; unpack8(x1, a); unpack8(x2, b);
    const f32x4 c0 = *(const f32x4*)cs, c1 = *(const f32x4*)(cs + 4), s0 = *(const f32x4*)sn, s1 = *(const f32x4*)(sn + 4);
#pragma unroll
    for (int j = 0; j < 8; ++j) { const float c = j < 4 ? c0[j & 3] : c1[j & 3], s = j < 4 ? s0[j & 3] : s1[j & 3]; o1[j] = a[j] * c - b[j] * s; o2[j] = a[j] * s + b[j] * c; }
    y1 = pack8f(o1); y2 = pack8f(o2);
    if (acc1) {
        float r1[8], r2[8]; unpack8(y1, r1); unpack8(y2, r2);
#pragma unroll
        for (int j = 0; j < 8; ++j) { acc1[j] += r1[j]; acc2[j] += r2[j]; }
    }
}
__device__ __forceinline__ void p1e_phase(Frame& F) {
    bf16_t* LAT = (bf16_t*)(F.ws + WS_LAT); bf16_t* MQKV = (bf16_t*)(F.ws + WS_MQKV); bf16_t* KM = (bf16_t*)(F.ws + WS_KM);
    const float* csb = (const float*)(F.ws + WS_CSB); const float* csa = (const float*)(F.ws + WS_CSA);
    const float* g_q = ldp(F, 4); const float* g_kv = ldp(F, 6);
    const int tid = tid_(), lane = tid & 63, wave = __builtin_amdgcn_readfirstlane(tid >> 6);
    for (int u = F.vcu; u < 256; u += F.G) {
        const int rb = u >> 2, cg = u & 3, m0 = rb * 256, pos0 = (rb & 31) * 256, b = rb >> 5, blk = rb & 31;
        if (cg == 0) {
            float gq[8], gk[8];
#pragma unroll
            for (int j = 0; j < 8; ++j) { gq[j] = lane < 48 ? g_q[8 * lane + j] : 0.f; gk[j] = lane < 32 ? g_kv[8 * lane + j] : 0.f; }
            for (int it = 0; it < 32; it += 4) {
                u32x4 a[4], k[4], c1[4], c2[4];
#pragma unroll
                for (int q = 0; q < 4; ++q) { bf16_t* row = LAT + (size_t)(m0 + wave * 32 + it + q) * NLAT;
                    a[q] = lane < 48 ? *(const u32x4*)(row + 8 * lane) : (u32x4){0u, 0u, 0u, 0u};
                    k[q] = lane < 32 ? *(const u32x4*)(row + QL + 8 * lane) : (u32x4){0u, 0u, 0u, 0u};
                    if (lane < 4) { c1[q] = *(const u32x4*)(row + QL + KVL + 8 * lane); c2[q] = *(const u32x4*)(row + QL + KVL + 32 + 8 * lane); } }
#pragma unroll
                for (int q = 0; q < 4; ++q) { bf16_t* row = LAT + (size_t)(m0 + wave * 32 + it + q) * NLAT; const int pos = pos0 + wave * 32 + it + q;
                    float fa[8], fk[8]; unpack8(a[q], fa); unpack8(k[q], fk);
                    float sa = 0.f, sk = 0.f;
#pragma unroll
                    for (int j = 0; j < 8; ++j) { sa += fa[j] * fa[j]; sk += fk[j] * fk[j]; }
                    const float ra = 1.f / sqrtf(wave_sum(sa) * (1.f / QL) + EPS), rk = 1.f / sqrtf(wave_sum(sk) * (1.f / KVL) + EPS);
#pragma unroll
                    for (int j = 0; j < 8; ++j) { fa[j] *= ra * gq[j]; fk[j] *= rk * gk[j]; }
                    if (lane < 48) *(u32x4*)(row + 8 * lane) = pack8f(fa);
                    if (lane < 32) *(u32x4*)(row + QL + 8 * lane) = pack8f(fk);
                    if (lane < 4) { u32x4 y1, y2; rope8(c1[q], c2[q], csa + (size_t)pos * 32 + 8 * lane, csa + (size_t)SEQ * 32 + (size_t)pos * 32 + 8 * lane, y1, y2, nullptr, nullptr);
                        *(u32x4*)(row + QL + KVL + 8 * lane) = y1; *(u32x4*)(row + QL + KVL + 32 + 8 * lane) = y2; } }
            }
        } else if (cg == 1) {
            const int head = lane >> 3, c = lane & 7;
            for (int it = 0; it < 32; it += 4) {
                u32x4 x1[4], x2[4];
#pragma unroll
                for (int q = 0; q < 4; ++q) { const bf16_t* p = MQKV + (size_t)(m0 + wave * 32 + it + q) * NMOBA + head * 128 + 8 * c; x1[q] = *(const u32x4*)p; x2[q] = *(const u32x4*)(p + 64); }
#pragma unroll
                for (int q = 0; q < 4; ++q) { bf16_t* p = MQKV + (size_t)(m0 + wave * 32 + it + q) * NMOBA + head * 128 + 8 * c; const int pos = pos0 + wave * 32 + it + q;
                    u32x4 y1, y2; rope8(x1[q], x2[q], csb + (size_t)pos * 64 + 8 * c, csb + (size_t)SEQ * 64 + (size_t)pos * 64 + 8 * c, y1, y2, nullptr, nullptr);
                    *(u32x4*)p = y1; *(u32x4*)(p + 64) = y2; }
            }
        } else {
            const int rsub = lane >> 5, head = 4 * (cg - 2) + ((lane >> 3) & 3), c = lane & 7;
            float s1[8], s2[8];
#pragma unroll
            for (int j = 0; j < 8; ++j) { s1[j] = 0.f; s2[j] = 0.f; }
            for (int it = 0; it < 16; it += 4) {
                u32x4 x1[4], x2[4];
#pragma unroll
                for (int q = 0; q < 4; ++q) { const bf16_t* p = MQKV + (size_t)(m0 + wave * 32 + 2 * (it + q) + rsub) * NMOBA + 1024 + head * 128 + 8 * c; x1[q] = *(const u32x4*)p; x2[q] = *(const u32x4*)(p + 64); }
#pragma unroll
                for (int q = 0; q < 4; ++q) { bf16_t* p = MQKV + (size_t)(m0 + wave * 32 + 2 * (it + q) + rsub) * NMOBA + 1024 + head * 128 + 8 * c; const int pos = pos0 + wave * 32 + 2 * (it + q) + rsub;
                    u32x4 y1, y2; rope8(x1[q], x2[q], csb + (size_t)pos * 64 + 8 * c, csb + (size_t)SEQ * 64 + (size_t)pos * 64 + 8 * c, y1, y2, s1, s2);
                    *(u32x4*)p = y1; *(u32x4*)(p + 64) = y2; }
            }
            LAS float* part = (LAS float*)F.lds;
#pragma unroll
            for (int j = 0; j < 8; ++j) { s1[j] += __shfl_xor(s1[j], 32); s2[j] += __shfl_xor(s2[j], 32); }
            if (lane < 32) {
#pragma unroll
                for (int j = 0; j < 8; ++j) { part[(wave * 32 + lane) * 16 + j] = s1[j]; part[(wave * 32 + lane) * 16 + 8 + j] = s2[j]; } }
            LDS_WAIT(); __syncthreads();
            { const int l2 = tid >> 4, v = tid & 15; float s = 0.f;
#pragma unroll
              for (int w = 0; w < 8; ++w) s += part[(w * 32 + l2) * 16 + v];
              const int hd = 4 * (cg - 2) + (l2 >> 3), cc = l2 & 7, dim = v < 8 ? 8 * cc + v : 64 + 8 * cc + (v - 8);
              KM[((size_t)(b * 8 + hd) * 32 + blk) * 128 + dim] = (bf16_t)f2bf(s * (1.f / 256.f)); }
            LDS_WAIT(); __syncthreads();
        }
    }
}

__device__ __forceinline__ void p4e_phase(Frame& F, int b) {
    const bf16_t* G = (const bf16_t*)(F.ws + WS_G); bf16_t* ACT = (bf16_t*)(F.ws + WS_ACT) + (size_t)b * SEQ * DFF;
    const float* cw = ldp(F, 13); const float* cb = ldp(F, 14);
    const int gt = F.vcu * (NWAVES * 64) + tid_(), NGT = F.G * NWAVES * 64;
    constexpr int NCH = DFF / 8, RG = 8, NTASK = (SEQ / RG) * NCH;
    for (int task = gt; task < NTASK; task += NGT) {
        const int rg = task / NCH, ch = task - rg * NCH, c = ch * 8, r0 = rg * RG;
        float w0a[8], w1a[8], w2a[8], ba[8], w0b[8], w1b[8], w2b[8], bb[8];
#pragma unroll
        for (int j = 0; j < 8; ++j) { w0a[j] = cw[c + j]; w1a[j] = cw[NUP + c + j]; w2a[j] = cw[2 * NUP + c + j]; ba[j] = cb[c + j];
            w0b[j] = cw[DFF + c + j]; w1b[j] = cw[NUP + DFF + c + j]; w2b[j] = cw[2 * NUP + DFF + c + j]; bb[j] = cb[DFF + c + j]; }
        float p2a[8], p1a[8], p2b[8], p1b[8];
        { u32x4 z = {0u, 0u, 0u, 0u};
          const u32x4 t2a = r0 >= 2 ? *(const u32x4*)(G + (size_t)(r0 - 2) * NUP + c) : z, t2b = r0 >= 2 ? *(const u32x4*)(G + (size_t)(r0 - 2) * NUP + DFF + c) : z;
          const u32x4 t1a = r0 >= 1 ? *(const u32x4*)(G + (size_t)(r0 - 1) * NUP + c) : z, t1b = r0 >= 1 ? *(const u32x4*)(G + (size_t)(r0 - 1) * NUP + DFF + c) : z;
          unpack8(t2a, p2a); unpack8(t2b, p2b); unpack8(t1a, p1a); unpack8(t1b, p1b); }
        u32x4 ca[RG], cbv[RG];
#pragma unroll
        for (int r = 0; r < RG; ++r) { ca[r] = *(const u32x4*)(G + (size_t)(r0 + r) * NUP + c); cbv[r] = *(const u32x4*)(G + (size_t)(r0 + r) * NUP + DFF + c); }
#pragma unroll
        for (int r = 0; r < RG; ++r) {
            float xa[8], xb[8], o[8]; unpack8(ca[r], xa); unpack8(cbv[r], xb);
#pragma unroll
            for (int j = 0; j < 8; ++j) {
                const float u1 = ba[j] + w0a[j] * p2a[j] + w1a[j] * p1a[j] + w2a[j] * xa[j];
                const float u2 = bb[j] + w0b[j] * p2b[j] + w1b[j] * p1b[j] + w2b[j] * xb[j];
                o[j] = u1 * sigmoidf_(u1) * u2;
                p2a[j] = p1a[j]; p1a[j] = xa[j]; p2b[j] = p1b[j]; p1b[j] = xb[j];
            }
            *(u32x4*)(ACT + (size_t)(r0 + r) * DFF + c) = pack8f(o);
        }
    }
}


#ifndef DIAG
#define DIAG 0
#endif
constexpr int CW_DIAG = 2;
#if DIAG
__device__ __forceinline__ float bf2f(bf16_t v) { return __builtin_bit_cast(float, (unsigned)v << 16); }
__device__ __forceinline__ float rbf(float v) { return __builtin_bit_cast(float, f2bf(v) << 16); }
__device__ __forceinline__ void diag_flag(Frame& F, unsigned bit) { __hip_atomic_fetch_or((unsigned*)(F.ctl + CW_DIAG), bit, __ATOMIC_RELAXED, __HIP_MEMORY_SCOPE_AGENT); }
__device__ __forceinline__ unsigned hsh(unsigned x) { x ^= x >> 16; x *= 0x7feb352du; x ^= x >> 15; x *= 0x846ca68bu; x ^= x >> 16; return x; }
__device__ __forceinline__ void diag_rope_kmean(Frame& F) {
    const bf16_t* XN = (const bf16_t*)(F.ws + WS_XN); const bf16_t* Win = (const bf16_t*)(F.ws + WS_WIN);
    const bf16_t* LAT = (const bf16_t*)(F.ws + WS_LAT); const bf16_t* MQKV = (const bf16_t*)(F.ws + WS_MQKV); const bf16_t* KM = (const bf16_t*)(F.ws + WS_KM);
    const int gt = blockIdx.x * 512 + threadIdx.x, NGT = gridDim.x * 512;
    constexpr int NS = 48, PER = 8 * 2 * 64 + 32;
    for (int task = gt; task < NS * PER; task += NGT) {
        const int smp = task / PER, r = task - smp * PER; const int m = (int)(hsh(smp * 7919u + 13u) % (unsigned)M), pos = m & (SEQ - 1);
        int n1, n2; float inv; const bf16_t* got1; const bf16_t* got2;
        if (r < 1024) { const int which = r >> 9, h = (r >> 6) & 7, d = r & 63; n1 = NLAT + which * 1024 + h * 128 + d; n2 = n1 + 64; inv = powf(10000.0f, -(float)d / 64.0f);
            got1 = MQKV + (size_t)m * NMOBA + which * 1024 + h * 128 + d; got2 = got1 + 64; }
        else { const int d = r - 1024; n1 = QL + KVL + d; n2 = n1 + 32; inv = powf(10000.0f, -(float)d / 32.0f); got1 = LAT + (size_t)m * NLAT + n1; got2 = got1 + 32; }
        float x1 = 0.f, x2 = 0.f;
        for (int k = 0; k < DM; ++k) { const float a = bf2f(XN[(size_t)m * DM + k]); x1 += a * bf2f(Win[(size_t)n1 * DM + k]); x2 += a * bf2f(Win[(size_t)n2 * DM + k]); }
        x1 = rbf(x1); x2 = rbf(x2);
        const float ang = (float)pos * inv, c = cosf(ang), sn = sinf(ang);
        const float y1 = x1 * c - x2 * sn, y2 = x1 * sn + x2 * c, tol = 0.02f * (fabsf(x1) + fabsf(x2)) + 0.02f;
        if (!(fabsf(bf2f(*got1) - y1) <= tol) || !(fabsf(bf2f(*got2) - y2) <= tol)) diag_flag(F, 1u);
    }
    for (int task = gt; task < 16 * 32 * 128; task += NGT) {
        const int bh = task >> 12, blk = (task >> 7) & 31, d = task & 127, b = bh >> 3, h = bh & 7;
        float s = 0.f;
        for (int rr = 0; rr < 256; ++rr) s += bf2f(MQKV[(size_t)(b * SEQ + blk * 256 + rr) * NMOBA + 1024 + h * 128 + d]);
        s *= (1.f / 256.f);
        if (!(fabsf(bf2f(KM[task]) - s) <= 0.01f * fabsf(s) + 2e-3f)) diag_flag(F, 8u);
    }
}
template <bool MOBA>
__device__ __forceinline__ void diag_attn(Frame& F) {
    LAS float* sc = (LAS float*)F.lds;
    LAS float* qv = sc + 8192;
    LAS float* red = qv + 192;
    LAS float* misc = red + 512;
    const int tid = threadIdx.x;
    constexpr int NS = 96;
    for (int smp = blockIdx.x; smp < NS; smp += gridDim.x) {
        const unsigned hv = hsh(smp * 104729u + (MOBA ? 77u : 5u));
        const int bh = hv & 15, b = bh >> 3, h = bh & 7; int t = (hv >> 4) % SEQ; if (smp < 8) t = (smp & 1) ? 256 * (smp >> 1) + 255 : 256 * (smp >> 1);
        const int qb = t >> 8;
        __syncthreads();
        if (MOBA) { if (tid < 128) qv[tid] = bf2f(((const bf16_t*)(F.ws + WS_MQKV))[(size_t)(b * SEQ + t) * NMOBA + h * 128 + tid]); }
        else { if (tid < 192) { const bf16_t* q = (const bf16_t*)(F.ws + WS_Q) + (size_t)(b * SEQ + t) * NQ + h * 192; float v = bf2f(q[tid]);
                   if (tid >= 128) { const int d = tid - 128, i = d & 31; const float ang = (float)t * powf(10000.0f, -(float)i / 32.0f), c = cosf(ang), sn = sinf(ang);
                       const float x1 = bf2f(q[128 + i]), x2 = bf2f(q[160 + i]); v = d < 32 ? x1 * c - x2 * sn : x1 * sn + x2 * c; v = rbf(v); }
                   qv[tid] = v; } }
        __syncthreads();
        int sel0 = -1, sel1 = -1, sel2 = -1;
        if (MOBA) {
            if (tid < 32) { float g = -__builtin_inff(); if (tid < qb) { g = 0.f; const bf16_t* km = (const bf16_t*)(F.ws + WS_KM) + ((size_t)bh * 32 + tid) * 128; for (int d = 0; d < 128; ++d) g += qv[d] * bf2f(km[d]); } misc[tid] = g; }
            __syncthreads();
            if (tid == 0) { int s0 = -1, s1 = -1, s2 = -1; float v0 = -__builtin_inff(), v1 = v0, v2 = v0;
                for (int j = 0; j < 32; ++j) { const float x = misc[j]; if (x > v0) { v2 = v1; s2 = s1; v1 = v0; s1 = s0; v0 = x; s0 = j; } else if (x > v1) { v2 = v1; s2 = s1; v1 = x; s1 = j; } else if (x > v2) { v2 = x; s2 = j; } }
                misc[32] = (float)s0; misc[33] = (float)s1; misc[34] = (float)s2; }
            __syncthreads();
            sel0 = (int)misc[32]; sel1 = (int)misc[33]; sel2 = (int)misc[34];
        }
        const float scale = MOBA ? 0.08838834764831845f : 0.07216878364870322f;
        float lmax = -__builtin_inff();
        for (int key = tid; key <= t; key += 512) {
            float s = -__builtin_inff(); const int kblk = key >> 8;
            const bool use = MOBA ? (kblk == qb || kblk == sel0 || kblk == sel1 || kblk == sel2) : true;
            if (use) { s = 0.f;
                if (MOBA) { const bf16_t* k = (const bf16_t*)(F.ws + WS_MQKV) + (size_t)(b * SEQ + key) * NMOBA + 1024 + h * 128; for (int d = 0; d < 128; ++d) s += qv[d] * bf2f(k[d]); }
                else { const bf16_t* k = (const bf16_t*)(F.ws + WS_KV) + (size_t)(b * SEQ + key) * NKV + h * 256; for (int d = 0; d < 128; ++d) s += qv[d] * bf2f(k[d]);
                       const bf16_t* kr = (const bf16_t*)(F.ws + WS_LAT) + (size_t)(b * SEQ + key) * NLAT + QL + KVL; for (int d = 0; d < 64; ++d) s += qv[128 + d] * bf2f(kr[d]); }
                s *= scale; }
            sc[key] = s; lmax = fmaxf(lmax, s);
        }
        red[tid] = lmax; __syncthreads();
        for (int o = 256; o > 0; o >>= 1) { if (tid < o) red[tid] = fmaxf(red[tid], red[tid + o]); __syncthreads(); }
        const float mx = red[0]; __syncthreads();
        float lsum = 0.f;
        for (int key = tid; key <= t; key += 512) { const float p = __expf(sc[key] - mx); sc[key] = p; lsum += p; }
        red[tid] = lsum; __syncthreads();
        for (int o = 256; o > 0; o >>= 1) { if (tid < o) red[tid] += red[tid + o]; __syncthreads(); }
        const float ltot = red[0]; __syncthreads();
        const int d = tid & 127, part = tid >> 7; float acc = 0.f;
        for (int key = part; key <= t; key += 4) { const float p = sc[key]; if (p != 0.f) {
            const bf16_t* v = MOBA ? (const bf16_t*)(F.ws + WS_MQKV) + (size_t)(b * SEQ + key) * NMOBA + 2048 + h * 128 : (const bf16_t*)(F.ws + WS_KV) + (size_t)(b * SEQ + key) * NKV + h * 256 + 128;
            acc += p * bf2f(v[d]); } }
        red[tid] = acc; __syncthreads();
        if (tid < 128) { const float o = (red[tid] + red[tid + 128] + red[tid + 256] + red[tid + 384]) / ltot; misc[40] = 0.f; red[tid] = o; }
        __syncthreads();
        if (tid < 128) { float mo = 0.f; for (int j = 0; j < 128; ++j) mo = fmaxf(mo, fabsf(red[j]));
            const float got = bf2f(((const bf16_t*)(F.ws + (MOBA ? WS_YB : WS_YA)))[(size_t)(b * SEQ + t) * DM + h * 128 + tid]);
            if (!(fabsf(got - red[tid]) <= 0.02f * mo + 1e-3f)) diag_flag(F, MOBA ? 4u : 2u); }
        __syncthreads();
    }
}
#endif

constexpr int N_PHASES = 16;
struct Args { const float* in[17]; float* out; unsigned char* ws; int ph_lo, ph_hi, li, pad; };
__global__ void __launch_bounds__(NWAVES * 64, 2) fwd_kernel(Args args) {
    extern __shared__ __attribute__((aligned(16))) unsigned char lds[];
    Frame F;
    F.lds = (LAS unsigned char*)lds;
    F.MISC = (volatile LAS unsigned*)(F.lds + MISC_OFF);
    F.G = gridDim.x; { const int bx = blockIdx.x; F.vcu = (F.G % 8 == 0) ? (bx % 8) * (F.G / 8) + bx / 8 : bx; }
    F.ws = args.ws; F.ctl = (gu32*)(args.ws + WS_CTL); F.out = args.out;
    for (int u = threadIdx.x; u < (LDS_BYTES - LDSCTL_OFF) / 4; u += NWAVES * 64) ((LAS unsigned*)(F.lds + LDSCTL_OFF))[u] = 0u;
    __syncthreads();
    if (threadIdx.x == 0) {
#pragma unroll
        for (int i = 0; i < 17; ++i) { const unsigned long long v = (unsigned long long)(uintptr_t)args.in[i]; F.MISC[32 + 2 * i] = (unsigned)v; F.MISC[33 + 2 * i] = (unsigned)(v >> 32); } }
    __syncthreads();
    const int lo = args.ph_lo, hi = args.ph_hi;
    const bool multi = (hi - lo) > 1;
    XcdBarrier bar; bar.bar = (unsigned*)(F.ctl + CW_BAR); bar.x = 0; bar.st = nullptr;
    if (multi) bar = xcd_barrier_post((unsigned*)(F.ctl + CW_BAR), F.MISC + 8);
#ifndef PHMASK
#define PHMASK 0xffff
#endif
#define IN(k) (((PHMASK >> (k)) & 1) && lo <= (k) && (k) < hi)
#define SEAM(k) do { if (IN((k) + 1)) xcd_barrier(bar); } while (0)
#ifndef REPMASK
#define REPMASK 0
#endif
#define REPS(k) _Pragma("unroll 1") for (int rep_ = 0; rep_ < (((REPMASK >> (k)) & 1) ? 2 : 1); ++rep_)
#define PH_BEGIN unsigned long long ws__ = (unsigned long long)(uintptr_t)F.ws; asm volatile("" : "+s"(ws__)); unsigned char* ws = (unsigned char*)(GAS unsigned char*)ws__; \
    unsigned long long out__ = (unsigned long long)(uintptr_t)F.out; asm volatile("" : "+s"(out__)); float* outp = (float*)(GAS float*)out__; bf16_t* GATE = (bf16_t*)outp; (void)GATE; (void)ws;

    if (IN(0)) { REPS(0) p0_prologue(F); SEAM(0); }

    if (IN(1)) { PH_BEGIN
        pg8::Gemm g{(const bf16_t*)(ws + WS_XN), (const bf16_t*)(ws + WS_WIN), M, NIN, DM, DM}; pg8::StaticOrder S; S.init(M, NIN, F.G, (int)blockIdx.x);
        pg8::EpiBf16R E{(bf16_t*)(ws + WS_LAT), NLAT, 3, (bf16_t*)(ws + WS_MQKV), NMOBA, 15, GATE, NGATE};
        REPS(1) pg8::gemm_phase(F.lds, g, S, E);
        SEAM(1);
    }
    if (IN(2)) { p1e_phase(F);
#if DIAG
        xcd_barrier(bar); diag_rope_kmean(F);
#endif
        SEAM(2); }

    if (IN(3)) { PH_BEGIN
        REPS(3) for (int it = F.vcu; it < 256; it += F.G) {
            const int bh = it >> 4, s = it & 15, b = bh >> 3, h = bh & 7;
            att::Head T;
            const bf16_t* base = (const bf16_t*)(ws + WS_MQKV) + (size_t)b * SEQ * NMOBA + h * 128;
            T.Q = base; T.K = base + 1024; T.KR = nullptr; T.V = base + 2048;
            T.O = (bf16_t*)(ws + WS_YB) + (size_t)b * SEQ * DM + h * 128; T.cosT = nullptr; T.sinT = nullptr;
            T.KM = (const bf16_t*)(ws + WS_KM) + (size_t)bh * 32 * 128;
#pragma unroll 1
#if MOBA_DENSE
            for (int pass = 0; pass < 2; ++pass) att::attn_block<true>(T, pass ? s : 31 - s, (char*)lds);
#else
            for (int pass = 0; pass < 2; ++pass) att::moba_block(T, pass ? s : 31 - s, (char*)lds);
#endif
        }
#if DIAG
        xcd_barrier(bar); diag_attn<true>(F);
#endif
        SEAM(3);
    }
    if (IN(4)) { PH_BEGIN
        { pg8::Gemm g{(const bf16_t*)(ws + WS_LAT), (const bf16_t*)(ws + WS_WUQ), M, NQ, QL, NLAT}; pg8::StaticOrder S; S.init(M, NQ, F.G, (int)blockIdx.x);
          pg8::EpiBf16R E{(bf16_t*)(ws + WS_Q), NQ, 1 << 20, nullptr, 0, 1 << 20, nullptr, 0};
          pg8::gemm_phase(F.lds, g, S, E); }
        { pg8::Gemm g{(const bf16_t*)(ws + WS_LAT) + QL, (const bf16_t*)(ws + WS_WUKV), M, NKV, KVL, NLAT}; pg8::StaticOrder S; S.init(M, NKV, F.G, (int)blockIdx.x);
          pg8::EpiBf16R E{(bf16_t*)(ws + WS_KV), NKV, 1 << 20, nullptr, 0, 1 << 20, nullptr, 0};
          pg8::gemm_phase(F.lds, g, S, E); }
        SEAM(4);
    }
    if (IN(5)) { PH_BEGIN
        REPS(5) for (int it = F.vcu; it < 256; it += F.G) {
            const int bh = it >> 4, s = it & 15, b = bh >> 3, h = bh & 7;
            att::Head T;
            T.Q = (const bf16_t*)(ws + WS_Q) + (size_t)b * SEQ * NQ + h * 192;
            T.K = (const bf16_t*)(ws + WS_KV) + (size_t)b * SEQ * NKV + h * 256;
            T.KR = (const bf16_t*)(ws + WS_LAT) + (size_t)b * SEQ * NLAT + QL + KVL;
            T.V = T.K + 128;
            T.O = (bf16_t*)(ws + WS_YA) + (size_t)b * SEQ * DM + h * 128;
            T.cosT = (const float*)(ws + WS_CSA); T.sinT = T.cosT + (size_t)SEQ * 32; T.KM = nullptr;
#pragma unroll 1
            for (int pass = 0; pass < 2; ++pass) att::attn_block<false>(T, pass ? s : 31 - s, (char*)lds);
        }
#if DIAG
        xcd_barrier(bar); diag_attn<false>(F);
#endif
        SEAM(5);
    }
    if (IN(6)) { PH_BEGIN
        pg8::Gemm g{(const bf16_t*)(ws + WS_YA), (const bf16_t*)(ws + WS_WOA), M, DM, DM, DM}; pg8::StaticOrder S; S.init(M, DM, F.G, (int)blockIdx.x);
        pg8::EpiGateF32 E{(float*)(ws + WS_T), GATE, ldp(F, 3), 0};
        REPS(6) pg8::gemm_phase(F.lds, g, S, E);
        SEAM(6);
    }
    if (IN(7)) { PH_BEGIN
        pg8::Gemm g{(const bf16_t*)(ws + WS_YB), (const bf16_t*)(ws + WS_WOB), M, DM, DM, DM}; pg8::StaticOrder S; S.init(M, DM, F.G, (int)blockIdx.x);
        pg8::EpiGateAddBf16 E{(bf16_t*)(ws + WS_Z), (const float*)(ws + WS_T), GATE, ldp(F, 3), DM};
        pg8::gemm_phase(F.lds, g, S, E);
        SEAM(7);
    }
    if (IN(8)) { PH_BEGIN
        pg8::Gemm g{(const bf16_t*)(ws + WS_Z), (const bf16_t*)(ws + WS_WOUT), M, DM, DM, DM}; pg8::StaticOrder S; S.init(M, DM, F.G, (int)blockIdx.x);
        pg8::EpiResF32 E{ldp(F, 0), outp};
        REPS(8) pg8::gemm_phase(F.lds, g, S, E);
        SEAM(8);
    }
    if (IN(9)) { PH_BEGIN
        const int tid = tid_(), lane = tid & 63, wave = __builtin_amdgcn_readfirstlane(tid >> 6);
        const int gw = F.vcu * NWAVES + wave, NGW = F.G * NWAVES; bf16_t* XN2 = (bf16_t*)(ws + WS_XN2); const float* g_ = ldp(F, 11);
        for (int m = gw; m < M; m += NGW) rms_row_to_bf16(lane, outp + (size_t)m * DM, g_, XN2 + (size_t)m * DM);
        SEAM(9);
    }
#pragma unroll 1
    for (int b = 0; b < 2; ++b) {
        if (IN(10 + 2 * b)) { PH_BEGIN
            pg8::Gemm g{(const bf16_t*)(ws + WS_XN2) + (size_t)b * SEQ * DM, (const bf16_t*)(ws + WS_WUP), SEQ, NUP, DM, DM}; pg8::StaticOrder S; S.init(SEQ, NUP, F.G, (int)blockIdx.x);
            pg8::EpiBf16R E{(bf16_t*)(ws + WS_G), NUP, 1 << 20, nullptr, 0, 1 << 20, nullptr, 0};
            REPS(10) pg8::gemm_phase(F.lds, g, S, E);
            SEAM(10 + 2 * b);
        }
        if (IN(11 + 2 * b)) { p4e_phase(F, b); SEAM(11 + 2 * b); }
    }
    if (IN(14)) { PH_BEGIN
        pg8::Gemm g{(const bf16_t*)(ws + WS_ACT), (const bf16_t*)(ws + WS_WDN), M, DM, DFF, DFF}; pg8::StaticOrder S; S.init(M, DM, F.G, (int)blockIdx.x);
        pg8::EpiResF32 E{outp, outp};
        pg8::gemm_phase(F.lds, g, S, E);
        SEAM(14);
    }
    if (IN(15)) { PH_BEGIN
        const int tid = tid_(), lane = tid & 63, wave = __builtin_amdgcn_readfirstlane(tid >> 6);
        const int gw = F.vcu * NWAVES + wave, NGW = F.G * NWAVES; const float* g_ = ldp(F, 16);
        for (int m = gw; m < M; m += NGW) rms_row_f32(lane, outp + (size_t)m * DM, g_, outp + (size_t)m * DM);
#if DIAG
        xcd_barrier(bar);
        if (blockIdx.x == 0 && threadIdx.x == 0) { const unsigned code = __hip_atomic_load((unsigned*)(F.ctl + CW_DIAG), RLX_AGENT); if (code) outp[0] = 1000.f * (float)code; }
#endif
    }
#undef IN
#undef SEAM
}

extern "C" void kernel_launch(void* const* d_in, const int* in_sizes, int n_in, void* d_out, int out_size, void* d_ws, size_t ws_size, hipStream_t stream) {
    static int grid = 0;
    if (grid == 0) {
        if (n_in != 17 || in_sizes[0] != M * DM || out_size != M * DM || ws_size < WS_END) {
            fprintf(stderr, "kernel_launch: unexpected shapes: n_in %d in0 %d out %d ws %zu; nothing launched\n", n_in, n_in > 0 ? in_sizes[0] : -1, out_size, ws_size); grid = -1; return; }
        int dev = 0, cus = 0;
        if (hipGetDevice(&dev) != hipSuccess || hipDeviceGetAttribute(&cus, hipDeviceAttributeMultiprocessorCount, dev) != hipSuccess) { grid = -1; return; }
        if (hipFuncSetAttribute((const void*)fwd_kernel, hipFuncAttributeMaxDynamicSharedMemorySize, LDS_BYTES) != hipSuccess) { fprintf(stderr, "kernel_launch: hipFuncSetAttribute failed\n"); grid = -1; return; }
        int per_cu = 0;
        if (hipOccupancyMaxActiveBlocksPerMultiprocessor(&per_cu, (const void*)fwd_kernel, NWAVES * 64, LDS_BYTES) != hipSuccess || per_cu < 1)
            fprintf(stderr, "kernel_launch: note: occupancy query reports %d workgroups per CU\n", per_cu);
        (void)hipGetLastError();
        grid = cus;
    }
    if (grid < 0) return;
    if (hipMemsetAsync((char*)d_ws + WS_CTL, 0, CTL_ZERO_BYTES, stream) != hipSuccess) { fprintf(stderr, "kernel_launch: memset failed\n"); return; }
    Args a{};
    for (int i = 0; i < 17; ++i) a.in[i] = (const float*)d_in[i];
    a.out = (float*)d_out; a.ws = (unsigned char*)d_ws;
#if MK_N_LAUNCHES == 1
    a.ph_lo = 0; a.ph_hi = N_PHASES; a.li = 0;
    hipLaunchKernelGGL(fwd_kernel, dim3(grid), dim3(NWAVES * 64), LDS_BYTES, stream, a);
#else
    for (int li = 0; li < N_PHASES; ++li) { a.ph_lo = li; a.ph_hi = li + 1; a.li = li;
        hipLaunchKernelGGL(fwd_kernel, dim3(grid), dim3(NWAVES * 64), LDS_BYTES, stream, a); }
#endif
}
```

```cpp
#include <hip/hip_runtime.h>
#include <cstdio>
#include <cstdint>

#ifndef MOBA_DENSE
#define MOBA_DENSE 0
#endif
#ifndef MK_N_LAUNCHES
#define MK_N_LAUNCHES 1
#endif

#define GAS __attribute__((address_space(1)))
#define LAS __attribute__((address_space(3)))
typedef unsigned short bf16_t;
typedef short bf16x8 __attribute__((ext_vector_type(8)));
typedef short s16x4 __attribute__((ext_vector_type(4)));
typedef float f32x4 __attribute__((ext_vector_type(4)));
typedef float f32x2 __attribute__((ext_vector_type(2)));
typedef float f32x16 __attribute__((ext_vector_type(16)));
typedef unsigned u32x4 __attribute__((ext_vector_type(4)));
typedef unsigned u32x2 __attribute__((ext_vector_type(2)));

constexpr int DM = 1024, BATCH = 2, SEQ = 8192, M = BATCH * SEQ;
constexpr int QL = 384, KVL = 256, KPE = 64;
constexpr int NLAT = 768;
constexpr int NMOBA = 3072, NGATE = 2048;
constexpr int NIN = NLAT + NMOBA + NGATE;
constexpr int NQ = 1536, NKV = 2048;
constexpr int DFF = 2816, NUP = 2 * DFF;
constexpr int NH = 8;
constexpr float EPS = 1e-6f;
constexpr int NWAVES = 8;

constexpr size_t MiB = 1u << 20;
constexpr size_t WS_CTL = 0, CTL_ZERO_BYTES = 1 * MiB;
constexpr size_t WS_WIN = 1 * MiB;
constexpr size_t WS_WUQ = WS_WIN + (size_t)NIN * DM * 2;
constexpr size_t WS_WUKV = WS_WUQ + (size_t)NQ * QL * 2;
constexpr size_t WS_WOA = WS_WUKV + (size_t)NKV * KVL * 2;
constexpr size_t WS_WOB = WS_WOA + (size_t)DM * DM * 2;
constexpr size_t WS_WOUT = WS_WOB + (size_t)DM * DM * 2;
constexpr size_t WS_WUP = WS_WOUT + (size_t)DM * DM * 2;
constexpr size_t WS_WDN = WS_WUP + (size_t)NUP * DM * 2;
constexpr size_t WS_CSB = WS_WDN + (size_t)DM * DFF * 2;
constexpr size_t WS_CSA = WS_CSB + (size_t)SEQ * 64 * 4 * 2;
constexpr size_t WS_KM = WS_CSA + (size_t)SEQ * 32 * 4 * 2;
constexpr size_t WS_FIXED_END = WS_KM + (size_t)16 * 32 * 128 * 2;
constexpr size_t A0 = 44 * MiB;
static_assert(WS_FIXED_END <= A0, "fixed region");
constexpr size_t WS_LAT = A0;
constexpr size_t WS_MQKV = A0 + 24 * MiB;
constexpr size_t WS_XN = A0 + 152 * MiB;
constexpr size_t WS_Y = A0 + 136 * MiB;
constexpr size_t WS_Q = A0 + 88 * MiB;
constexpr size_t WS_KV = A0 + 24 * MiB;
constexpr size_t WS_Z = A0 + 88 * MiB;
constexpr size_t WS_XN2 = A0;
constexpr size_t WS_G = A0 + 32 * MiB;
constexpr size_t WS_ACT = A0 + 120 * MiB;
constexpr size_t WS_SS = A0 + 208 * MiB;
constexpr size_t WS_END = 256 * MiB;
static_assert(WS_ACT + (size_t)M * DFF * 2 <= WS_SS && WS_SS + (size_t)M * 16 * 4 <= WS_END && WS_Y + (size_t)M * 2048 * 2 <= WS_END, "ws map");

constexpr int CW_TMO = 0, CW_CODE = 1, CW_BAR = 4096;

constexpr int RING_BYTES = 131072;
constexpr int LDS_BYTES = 163840;
constexpr int LDSCTL_OFF = LDS_BYTES - 1024, MISC_OFF = LDSCTL_OFF + 320;

#define RLX_AGENT __ATOMIC_RELAXED, __HIP_MEMORY_SCOPE_AGENT
#define LDS_WAIT() asm volatile("s_waitcnt lgkmcnt(0)" ::: "memory")
#define VM_WAIT() asm volatile("s_waitcnt vmcnt(0)" ::: "memory")

__device__ __forceinline__ unsigned f2bf(float f) { unsigned u = __builtin_bit_cast(unsigned, f); return (u + 0x7fffu + ((u >> 16) & 1u)) >> 16; }
__device__ __forceinline__ unsigned pk2(float lo, float hi) { return f2bf(lo) | (f2bf(hi) << 16); }
__device__ __forceinline__ float bf_lo(unsigned w) { return __builtin_bit_cast(float, w << 16); }
__device__ __forceinline__ float bf_hi(unsigned w) { return __builtin_bit_cast(float, w & 0xffff0000u); }
__device__ __forceinline__ unsigned cvt_pk_bf16(float lo, float hi) { unsigned r; asm volatile("v_cvt_pk_bf16_f32 %0, %1, %2" : "=v"(r) : "v"(lo), "v"(hi)); return r; }
__device__ __forceinline__ float sigmoidf_(float x) { return __builtin_amdgcn_rcpf(1.f + __builtin_amdgcn_exp2f(-1.4426950408889634f * x)); }
__device__ __forceinline__ int tid_() { int t = threadIdx.x; asm volatile("" : "+v"(t)); return t; }
__device__ __forceinline__ float wave_sum(float v) {
#pragma unroll
    for (int o = 1; o < 64; o <<= 1) v += __shfl_xor(v, o);
    return v;
}

namespace pg8 {
constexpr int BM = 256, BK = 64, HALF = 128, HTB = HALF * BK * 2, STAGE_BYTES = 8 * HTB, NXCD = 8, WGM = 8;
__host__ __device__ __forceinline__ int lds_byte(int r, int c) { const int st = (r >> 4) * 2 + (c >> 5), rr = r & 15, cc = c & 31, ob = rr * 64 + cc * 2; return st * 1024 + (ob ^ (((ob >> 9) & 1) << 5)); }
__host__ __device__ __forceinline__ void stage_rc(int b, int& R, int& C) { const int st = b / 1024, sb = b % 1024, swz = sb ^ (((sb >> 9) & 1) << 5); R = (st >> 1) * 16 + swz / 64; C = (st & 1) * 32 + (swz % 64) / 2; }
__host__ __device__ __forceinline__ int perm32(int rho) { const int n = rho >> 4, i = rho & 15; return 8 * (i >> 2) + 4 * n + (i & 3); }

struct Unit { int pm, pn; };
struct Gemm { const bf16_t* A; const bf16_t* Bt; int M, N, K, lda; int halo; };
constexpr int HP = 33, HROWS = 254;
__device__ __forceinline__ long arow(const Gemm& g, int pm) { return g.halo ? (long)(pm / HP) * SEQ + (long)(pm % HP) * HROWS - 2 : (long)pm * BM; }

struct StaticOrder {
    int nM, nN, nwg, G, c;
    __host__ __device__ void init(int M_, int N_, int G_, int c_) { nM = M_ / BM; nN = N_ / BM; nwg = nM * nN; G = G_; c = c_; }
    __host__ __device__ bool next(int i, Unit& u) const {
        const long L = (long)i * G + c; if (L >= nwg) return false;
        int wgid = (int)L; { const int q = nwg / NXCD, r = nwg % NXCD, xcd = wgid % NXCD, off = wgid / NXCD; wgid = (xcd < r ? xcd * (q + 1) : r * (q + 1) + (xcd - r) * q) + off; }
        const int nig = WGM * nN, gid = wgid / nig, fm = gid * WGM, gsz = (nM - fm) < WGM ? (nM - fm) : WGM;
        u.pm = fm + ((wgid % nig) % gsz); u.pn = (wgid % nig) / gsz; return true;
    }
};

typedef f32x4 Acc[2][2][4][2];

struct EpiBf16R {
    static constexpr bool PERM = true;
    bf16_t* O0; int ld0; int t1; bf16_t* O1; int ld1; int t2; bf16_t* O2; int ld2;
    __device__ __forceinline__ void operator()(const Acc& acc, const Unit& u, int wr, int wc, int fr, int fq) const {
        bf16_t* base; int ldc, colt;
        if (u.pn < t1) { base = O0; ldc = ld0; colt = u.pn * BM; } else if (u.pn < t2) { base = O1; ldc = ld1; colt = (u.pn - t1) * BM; } else { base = O2; ldc = ld2; colt = (u.pn - t2) * BM; }
        const int row0 = u.pm * BM + wr * 64 + fr, col0 = colt + wc * 32 + 8 * fq;
#pragma unroll
        for (int ai = 0; ai < 2; ++ai)
#pragma unroll
            for (int m = 0; m < 4; ++m) { bf16_t* rowp = base + (size_t)(row0 + ai * HALF + m * 16) * ldc + col0;
#pragma unroll
                for (int bj = 0; bj < 2; ++bj) { const f32x4 v0 = acc[ai][bj][m][0], v1 = acc[ai][bj][m][1];
                    u32x4 w; w.x = cvt_pk_bf16(v0[0], v0[1]); w.y = cvt_pk_bf16(v0[2], v0[3]); w.z = cvt_pk_bf16(v1[0], v1[1]); w.w = cvt_pk_bf16(v1[2], v1[3]);
                    *(u32x4*)(rowp + bj * HALF) = w; } }
    }
};
struct EpiGate2 {
    static constexpr bool PERM = false, MID = true;
    bf16_t* Z; const bf16_t* gate; const float* gbias;
    __device__ __forceinline__ void mid(Acc& acc, const Unit& u, int wr, int wc, int fr, int fq) const {
        int opq = 0; asm volatile("" : "+v"(opq));
        const int row0 = u.pm * BM + wr * 64 + fr + opq, col0 = u.pn * BM + wc * 32 + 4 * fq;
        const char* gp = (const char*)gate;
#pragma unroll
        for (int bj = 0; bj < 2; ++bj)
#pragma unroll
            for (int n = 0; n < 2; ++n) { const int col = col0 + bj * HALF + n * 16;
                const f32x4 ba = *(const f32x4*)(gbias + col), bb = *(const f32x4*)(gbias + DM + col);
#pragma unroll
                for (int ai = 0; ai < 2; ++ai)
#pragma unroll
                    for (int m = 0; m < 4; ++m) { const unsigned goff = (unsigned)((row0 + ai * HALF + m * 16) * NGATE + col) * 2u;
                        const u32x2 ga = *(const u32x2*)(gp + goff), gb = *(const u32x2*)(gp + goff + DM * 2);
                        const float xa[4] = {bf_lo(ga.x) + ba[0], bf_hi(ga.x) + ba[1], bf_lo(ga.y) + ba[2], bf_hi(ga.y) + ba[3]};
                        const float xb[4] = {bf_lo(gb.x) + bb[0], bf_hi(gb.x) + bb[1], bf_lo(gb.y) + bb[2], bf_hi(gb.y) + bb[3]};
#pragma unroll
                        for (int j = 0; j < 4; ++j) { const float ea = __builtin_amdgcn_exp2f(-1.4426950408889634f * xa[j]), eb = __builtin_amdgcn_exp2f(-1.4426950408889634f * fmaxf(xb[j], -60.f));
                            acc[ai][bj][m][n][j] *= (1.f + eb) * __builtin_amdgcn_rcpf(1.f + ea); }
                        if (m & 1) asm volatile("" ::: "memory"); } }
    }
    __device__ __forceinline__ void operator()(const Acc& acc, const Unit& u, int wr, int wc, int fr, int fq) const {
        const int row0 = u.pm * BM + wr * 64 + fr, col0 = u.pn * BM + wc * 32 + 4 * fq;
        const char* gp = (const char*)gate; char* zp = (char*)Z;
#pragma unroll
        for (int bj = 0; bj < 2; ++bj)
#pragma unroll
            for (int n = 0; n < 2; ++n) { const int col = col0 + bj * HALF + n * 16;
                const f32x4 bb = *(const f32x4*)(gbias + DM + col);
#pragma unroll
                for (int ai = 0; ai < 2; ++ai)
#pragma unroll
                    for (int m = 0; m < 4; ++m) { const int row = row0 + ai * HALF + m * 16;
                        const u32x2 gb = *(const u32x2*)(gp + (unsigned)(row * NGATE + DM + col) * 2u);
                        const float xb[4] = {bf_lo(gb.x) + bb[0], bf_hi(gb.x) + bb[1], bf_lo(gb.y) + bb[2], bf_hi(gb.y) + bb[3]};
                        float o[4];
#pragma unroll
                        for (int j = 0; j < 4; ++j) o[j] = acc[ai][bj][m][n][j] * sigmoidf_(fmaxf(xb[j], -60.f));
                        u32x2 w; w.x = cvt_pk_bf16(o[0], o[1]); w.y = cvt_pk_bf16(o[2], o[3]);
                        *(u32x2*)(zp + (unsigned)(row * DM + col) * 2u) = w; } }
    }
};
struct EpiResNorm {
    static constexpr bool PERM = false;
    const float* base; float* out; bf16_t* xs; const float* g; float* ss;
    __device__ __forceinline__ void operator()(const Acc& acc, const Unit& u, int wr, int wc, int fr, int fq) const {
        const int row0 = u.pm * BM + wr * 64 + fr, col0 = u.pn * BM + wc * 32 + 4 * fq;
        f32x4 gv[2][2];
#pragma unroll
        for (int bj = 0; bj < 2; ++bj)
#pragma unroll
            for (int n = 0; n < 2; ++n) gv[bj][n] = *(const f32x4*)(g + col0 + bj * HALF + n * 16);
#pragma unroll
        for (int ai = 0; ai < 2; ++ai)
#pragma unroll
            for (int m = 0; m < 4; ++m) { const size_t row = (size_t)(row0 + ai * HALF + m * 16), off = row * DM + col0; float sq = 0.f;
#pragma unroll
                for (int bj = 0; bj < 2; ++bj)
#pragma unroll
                    for (int n = 0; n < 2; ++n) { const f32x4 b = *(const f32x4*)(base + off + bj * HALF + n * 16); const f32x4 x1 = b + acc[ai][bj][m][n];
                        *(f32x4*)(out + off + bj * HALF + n * 16) = x1; sq += (x1[0] * x1[0] + x1[1] * x1[1]) + (x1[2] * x1[2] + x1[3] * x1[3]);
                        const f32x4 y = x1 * gv[bj][n]; u32x2 w; w.x = cvt_pk_bf16(y[0], y[1]); w.y = cvt_pk_bf16(y[2], y[3]); *(u32x2*)(xs + off + bj * HALF + n * 16) = w; }
                sq += __shfl_xor(sq, 16); sq += __shfl_xor(sq, 32);
                if (fq == 0) ss[row * 16 + u.pn * 4 + wc] = sq; }
    }
};
struct EpiScaleBf16 {
    static constexpr bool PERM = true;
    bf16_t* O; int ldc; const float* ss; int rowbase;
    __device__ __forceinline__ void operator()(const Acc& acc, const Unit& u, int wr, int wc, int fr, int fq) const {
        const int row0 = u.pm * BM + wr * 64 + fr, col0 = u.pn * BM + wc * 32 + 8 * fq;
#pragma unroll
        for (int ai = 0; ai < 2; ++ai)
#pragma unroll
            for (int m = 0; m < 4; ++m) { const int row = row0 + ai * HALF + m * 16; const f32x4* sp = (const f32x4*)(ss + (size_t)(rowbase + row) * 16);
                const f32x4 s0 = sp[0], s1 = sp[1], s2 = sp[2], s3 = sp[3];
                const float tot = ((s0[0] + s0[1]) + (s0[2] + s0[3])) + ((s1[0] + s1[1]) + (s1[2] + s1[3])) + ((s2[0] + s2[1]) + (s2[2] + s2[3])) + ((s3[0] + s3[1]) + (s3[2] + s3[3]));
                const float rstd = 1.f / sqrtf(tot * (1.f / DM) + EPS);
                bf16_t* rowp = O + (size_t)row * ldc + col0;
#pragma unroll
                for (int bj = 0; bj < 2; ++bj) { const f32x4 v0 = acc[ai][bj][m][0] * rstd, v1 = acc[ai][bj][m][1] * rstd;
                    u32x4 w; w.x = cvt_pk_bf16(v0[0], v0[1]); w.y = cvt_pk_bf16(v0[2], v0[3]); w.z = cvt_pk_bf16(v1[0], v1[1]); w.w = cvt_pk_bf16(v1[2], v1[3]);
                    *(u32x4*)(rowp + bj * HALF) = w; } }
    }
};
struct EpiResF32 {
    static constexpr bool PERM = false;
    const float* base; float* out;
    __device__ __forceinline__ void operator()(const Acc& acc, const Unit& u, int wr, int wc, int fr, int fq) const {
        const int row0 = u.pm * BM + wr * 64 + fr, col0 = u.pn * BM + wc * 32 + 4 * fq;
#pragma unroll
        for (int ai = 0; ai < 2; ++ai)
#pragma unroll
            for (int m = 0; m < 4; ++m) { const size_t off = (size_t)(row0 + ai * HALF + m * 16) * DM + col0;
#pragma unroll
                for (int bj = 0; bj < 2; ++bj)
#pragma unroll
                    for (int n = 0; n < 2; ++n) { const f32x4 b = *(const f32x4*)(base + off + bj * HALF + n * 16); *(f32x4*)(out + off + bj * HALF + n * 16) = b + acc[ai][bj][m][n]; } }
    }
};


__device__ __forceinline__ float dpp_ror1(float v) { return __builtin_bit_cast(float, __builtin_amdgcn_update_dpp(0, __builtin_bit_cast(int, v), 0x121, 0xf, 0xf, false)); }
__device__ __forceinline__ float dpp_ror2(float v) { return __builtin_bit_cast(float, __builtin_amdgcn_update_dpp(0, __builtin_bit_cast(int, v), 0x122, 0xf, 0xf, false)); }
struct EpiConv {
    static constexpr bool PERM = true;
    bf16_t* ACT; const float* ss; const float* cw; const float* cb; LAS unsigned char* xl;
    __device__ __forceinline__ void operator()(Acc& acc, const Unit& u, int wr, int wc, int fr, int fq) const {
        const int P = u.pm, b = P / HP, p = P - HP * b, tok0 = HROWS * p - 2;
#pragma unroll
        for (int ai = 0; ai < 2; ++ai)
#pragma unroll
            for (int m = 0; m < 4; ++m) { const int tok = tok0 + ai * HALF + wr * 64 + m * 16 + fr; const int tc = tok < 0 ? 0 : (tok > SEQ - 1 ? SEQ - 1 : tok);
                const f32x4* sp = (const f32x4*)(ss + (size_t)(b * SEQ + tc) * 16);
                const f32x4 s0 = sp[0], s1 = sp[1], s2 = sp[2], s3 = sp[3];
                const float tot = ((s0[0] + s0[1]) + (s0[2] + s0[3])) + ((s1[0] + s1[1]) + (s1[2] + s1[3])) + ((s2[0] + s2[1]) + (s2[2] + s2[3])) + ((s3[0] + s3[1]) + (s3[2] + s3[3]));
                const float rstd = tok < 0 ? 0.f : 1.f / sqrtf(tot * (1.f / DM) + EPS);
#pragma unroll
                for (int bj = 0; bj < 2; ++bj)
#pragma unroll
                    for (int n = 0; n < 2; ++n) acc[ai][bj][m][n] = acc[ai][bj][m][n] * rstd; }
        const int slot = (wc * 4 + fq) * 2 + (fr - 14);
        if (fr >= 14) {
#pragma unroll
            for (int ai = 0; ai < 2; ++ai)
#pragma unroll
                for (int bj = 0; bj < 2; ++bj)
#pragma unroll
                    for (int n = 0; n < 2; ++n) *(LAS f32x4*)(xl + (((((ai * 2 + wr) * 32 + slot) * 2 + bj) * 2 + n) * 16)) = acc[ai][bj][3][n];
        }
        asm volatile("s_waitcnt lgkmcnt(0)" ::: "memory"); __builtin_amdgcn_s_barrier(); asm volatile("" ::: "memory");
        const int cbase = 128 * u.pn + 32 * wc + 8 * fq;
#pragma unroll
        for (int n = 0; n < 2; ++n) { const int cff = cbase + 4 * n;
            const f32x4 w0a = *(const f32x4*)(cw + cff), w1a = *(const f32x4*)(cw + NUP + cff), w2a = *(const f32x4*)(cw + 2 * NUP + cff), ba = *(const f32x4*)(cb + cff);
            const f32x4 w0b = *(const f32x4*)(cw + DFF + cff), w1b = *(const f32x4*)(cw + NUP + DFF + cff), w2b = *(const f32x4*)(cw + 2 * NUP + DFF + cff), bb = *(const f32x4*)(cb + DFF + cff);
#pragma unroll
            for (int ai = 0; ai < 2; ++ai) {
                f32x4 pv1 = {0.f, 0.f, 0.f, 0.f}, pv2 = {0.f, 0.f, 0.f, 0.f};
                if (fr >= 14 && (ai | wr)) { const int sai = wr ? ai : ai - 1, swr = wr ? 0 : 1;
                    pv1 = *(const LAS f32x4*)(xl + (((((sai * 2 + swr) * 32 + slot) * 2 + 0) * 2 + n) * 16)); pv2 = *(const LAS f32x4*)(xl + (((((sai * 2 + swr) * 32 + slot) * 2 + 1) * 2 + n) * 16)); }
#pragma unroll
                for (int m = 0; m < 4; ++m) { const f32x4 c1 = acc[ai][0][m][n], c2 = acc[ai][1][m][n]; float o[4];
#pragma unroll
                    for (int j = 0; j < 4; ++j) {
                        const float a1 = dpp_ror1(fr == 15 ? pv1[j] : c1[j]), a2 = dpp_ror2(fr >= 14 ? pv1[j] : c1[j]);
                        const float d1 = dpp_ror1(fr == 15 ? pv2[j] : c2[j]), d2 = dpp_ror2(fr >= 14 ? pv2[j] : c2[j]);
                        const float u1 = ba[j] + w0a[j] * a2 + w1a[j] * a1 + w2a[j] * c1[j];
                        const float u2 = bb[j] + w0b[j] * d2 + w1b[j] * d1 + w2b[j] * c2[j];
                        o[j] = u1 * sigmoidf_(u1) * u2; }
                    const int r = ai * HALF + wr * 64 + m * 16 + fr, tok = tok0 + r;
                    if (r >= 2 && tok < SEQ) { u32x2 w; w.x = cvt_pk_bf16(o[0], o[1]); w.y = cvt_pk_bf16(o[2], o[3]); *(u32x2*)(ACT + (size_t)(b * SEQ + tok) * DFF + cff) = w; }
                    pv1 = c1; pv2 = c2; }
            }
        }
    }
};
template <class E, class = void> struct epi_has_mid { static constexpr bool value = false; };
template <class E> struct epi_has_mid<E, decltype((void)E::MID)> { static constexpr bool value = E::MID; };
template <class Epi, class Sched, bool ALIGN_EPI = true>
__device__ __forceinline__ void gemm_phase(LAS unsigned char* lds, const Gemm g, const Sched& S, const Epi& E) {
    const int tid = tid_(), wid = __builtin_amdgcn_readfirstlane(tid >> 6), lane = tid & 63, wr = wid >> 2, wc = wid & 3, fr = lane & 15, fq = lane >> 4;
    const int K = g.K, nt = K / BK, lda = g.lda;
    unsigned voffA[2], voffB[2];
#pragma unroll
    for (int i = 0; i < 2; ++i) { int R, C; stage_rc(tid * 16 + i * 8192, R, C); const int Rb = Epi::PERM ? ((R & ~31) + perm32(R & 31)) : R;
        voffA[i] = (unsigned)(R * lda + C) * 2u; voffB[i] = (unsigned)(Rb * K + C) * 2u; }
    const size_t kstep = (size_t)(BK * 2);
    const size_t hstepA = (size_t)HALF * lda * 2, hstepB = (size_t)HALF * K * 2;
    const size_t tstepB = 2 * hstepB; const long rowbytes = (long)lda * 2;
    const unsigned ldsw = (unsigned)wid * 1024u;
    const int aoff = lds_byte(wr * 64 + fr, fq * 8), boff = lds_byte(wc * 32 + fr, fq * 8);
#define PG8_SA(b, h) (((b) * 2 + (h)) * HTB)
#define PG8_SB(b, h) ((4 + (b) * 2 + (h)) * HTB)
#define PG8_STAGE(bufoff, gbase, voff) do { _Pragma("unroll") for (int _i = 0; _i < 2; ++_i) \
        __builtin_amdgcn_global_load_lds((const unsigned*)((const char*)(gbase) + (voff)[_i]), (LAS unsigned*)(lds + (bufoff) + ldsw + _i * 8192), 16, 0, 0); } while (0)
#define PG8_LDA(dst, b, h) do { _Pragma("unroll") for (int m = 0; m < 4; ++m) _Pragma("unroll") for (int k = 0; k < 2; ++k) dst[m][k] = *(const LAS bf16x8*)(lds + PG8_SA(b, h) + aoff + m * 2048 + k * 1024); } while (0)
#define PG8_LDB(dst, b, h) do { _Pragma("unroll") for (int n = 0; n < 2; ++n) _Pragma("unroll") for (int k = 0; k < 2; ++k) dst[n][k] = *(const LAS bf16x8*)(lds + PG8_SB(b, h) + boff + n * 2048 + k * 1024); } while (0)
#define PG8_MMA(ai, bj, At, Bt) do { __builtin_amdgcn_s_setprio(1); _Pragma("unroll") for (int m = 0; m < 4; ++m) _Pragma("unroll") for (int n = 0; n < 2; ++n) _Pragma("unroll") for (int k = 0; k < 2; ++k) \
        acc[ai][bj][m][n] = __builtin_amdgcn_mfma_f32_16x16x32_bf16(Bt[n][k], At[m][k], acc[ai][bj][m][n], 0, 0, 0); __builtin_amdgcn_s_setprio(0); } while (0)
#define PG8_WAIT_V(n) asm volatile("s_waitcnt vmcnt(" #n ")" ::: "memory")
#define PG8_WAIT_L(n) asm volatile("s_waitcnt lgkmcnt(" #n ")" ::: "memory")
#define PG8_BAR __builtin_amdgcn_s_barrier()
#define PG8_SCHED __builtin_amdgcn_sched_barrier(0)
    Unit cur, nxt; int ui = 0;
    if (!S.next(0, cur)) return;
    Acc acc;
#pragma unroll
    for (int a = 0; a < 2; ++a)
#pragma unroll
        for (int b = 0; b < 2; ++b)
#pragma unroll
            for (int m = 0; m < 4; ++m)
#pragma unroll
                for (int n = 0; n < 2; ++n) acc[a][b][m][n] = (f32x4){0.f, 0.f, 0.f, 0.f};
    bf16x8 At[4][2], B0[2][2], B1[2][2];
    const char* cA = (const char*)g.A + arow(g, cur.pm) * rowbytes; const char* cB = (const char*)g.Bt + (size_t)cur.pn * tstepB;
    PG8_STAGE(PG8_SB(0, 0), cB, voffB); PG8_STAGE(PG8_SB(0, 1), cB + hstepB, voffB); PG8_STAGE(PG8_SA(0, 0), cA, voffA); PG8_STAGE(PG8_SA(0, 1), cA + hstepA, voffA);
    if (wr == 1) PG8_BAR;
    PG8_WAIT_V(2); PG8_BAR;
    PG8_STAGE(PG8_SB(1, 0), cB + kstep, voffB); PG8_STAGE(PG8_SA(1, 0), cA + kstep, voffA); PG8_STAGE(PG8_SB(1, 1), cB + hstepB + kstep, voffB);
    PG8_WAIT_V(6); PG8_BAR;
    for (;;) {
        const bool has_next = S.next(ui + 1, nxt);
        const char* nA = has_next ? (const char*)g.A + arow(g, nxt.pm) * rowbytes : cA; const char* nB = has_next ? (const char*)g.Bt + (size_t)nxt.pn * tstepB : cB;
        for (int t = 0; t < nt; t += 2) {
            const bool last = (t == nt - 2);
            if constexpr (epi_has_mid<Epi>::value) { if (t == nt / 2) E.mid(acc, cur, wr, wc, fr, fq); }
            const char* a1 = cA + (size_t)(t + 1) * kstep;
            const char* a2 = last ? nA : cA + (size_t)(t + 2) * kstep; const char* b2 = last ? nB : cB + (size_t)(t + 2) * kstep;
            const char* a3 = a2 + kstep; const char* b3 = b2 + kstep;
            PG8_LDB(B0, 0, 0); PG8_LDB(B1, 0, 1); PG8_SCHED; PG8_LDA(At, 0, 0); PG8_STAGE(PG8_SA(1, 1), a1 + hstepA, voffA);
            PG8_WAIT_V(8); PG8_WAIT_L(0); PG8_BAR; PG8_MMA(0, 0, At, B0); PG8_MMA(0, 1, At, B1); PG8_BAR; PG8_SCHED;
            PG8_LDA(At, 0, 1); PG8_STAGE(PG8_SB(0, 0), b2, voffB); PG8_STAGE(PG8_SB(0, 1), b2 + hstepB, voffB); PG8_STAGE(PG8_SA(0, 0), a2, voffA);
            PG8_WAIT_V(8); PG8_WAIT_L(0); PG8_BAR; PG8_MMA(1, 0, At, B0); PG8_MMA(1, 1, At, B1); PG8_BAR; PG8_SCHED;
            PG8_LDB(B0, 1, 0); PG8_LDB(B1, 1, 1); PG8_SCHED; PG8_LDA(At, 1, 0); PG8_STAGE(PG8_SA(0, 1), a2 + hstepA, voffA);
            PG8_WAIT_V(8); PG8_WAIT_L(0); PG8_BAR; PG8_MMA(0, 0, At, B0); PG8_MMA(0, 1, At, B1); PG8_BAR; PG8_SCHED;
            PG8_LDA(At, 1, 1); PG8_STAGE(PG8_SB(1, 0), b3, voffB); PG8_STAGE(PG8_SB(1, 1), b3 + hstepB, voffB); PG8_STAGE(PG8_SA(1, 0), a3, voffA);
            PG8_WAIT_V(8); PG8_WAIT_L(0); PG8_BAR; PG8_MMA(1, 0, At, B0); PG8_MMA(1, 1, At, B1); PG8_BAR; PG8_SCHED;
        }
        if constexpr (ALIGN_EPI) { if (wr == 0) PG8_BAR; }
        E(acc, cur, wr, wc, fr, fq);
        if (!has_next) break;
#pragma unroll
        for (int a = 0; a < 2; ++a)
#pragma unroll
            for (int b = 0; b < 2; ++b)
#pragma unroll
                for (int m = 0; m < 4; ++m)
#pragma unroll
                    for (int n = 0; n < 2; ++n) acc[a][b][m][n] = (f32x4){0.f, 0.f, 0.f, 0.f};
        cur = nxt; cA = nA; cB = nB; ++ui;
        if constexpr (ALIGN_EPI) { if (wr == 1) PG8_BAR; }
    }
    PG8_WAIT_V(0);
    if constexpr (!ALIGN_EPI) { if (wr == 0) PG8_BAR; }
    PG8_BAR;
#undef PG8_SA
#undef PG8_SB
#undef PG8_STAGE
#undef PG8_LDA
#undef PG8_LDB
#undef PG8_MMA
#undef PG8_WAIT_V
#undef PG8_WAIT_L
#undef PG8_BAR
#undef PG8_SCHED
}
}

namespace att {
constexpr int NW = 8, QBLK = 32, KVBLK = 64, QB = NW * QBLK;
constexpr int SHM_V = KVBLK * 128 * 2, SHM_K = KVBLK * 128 * 2, SHM_KR = KVBLK * 64 * 2;
constexpr int OFF_V = 0, OFF_K = 2 * SHM_V, OFF_KR = OFF_K + 2 * SHM_K, OFF_WS = OFF_KR + 2 * SHM_KR, ATT_LDS_BYTES = OFF_WS + NW * 64 * 4;
constexpr float THR = 8.f;
#define KSWZ(row, colB) ((row) * 256 + ((colB) ^ (((row) & 7) << 4)))
#define KRSWZ(row, colB) ((row) * 128 + ((colB) ^ (((row) & 7) << 4)))
#define SBAR() __builtin_amdgcn_sched_barrier(0)
__device__ __forceinline__ int v_st(int k, int c) { const int kk = (k & ~0xC) | ((k & 4) << 1) | ((k & 8) >> 1); return ((kk >> 3) * 4 + (c >> 5)) * 512 + ((kk & 7) * 32 + (c & 31)) * 2; }
__device__ __forceinline__ int v_rd_base(int lane) { return ((lane & 3) << 3) | (((lane >> 2) & 3) << 6) | (((lane >> 4) & 1) << 5) | (((lane >> 5) & 1) << 8); }
constexpr int v_rd_off(int d0, int ks, int half) { return d0 * 512 + ks * 4096 + half * 2048; }
__device__ __forceinline__ int crow(int r, int hi) { return (r & 3) + 8 * (r >> 2) + 4 * hi; }
__device__ __forceinline__ unsigned cvtpk(float lo, float hi) { unsigned r; asm volatile("v_cvt_pk_bf16_f32 %0, %1, %2" : "=v"(r) : "v"(lo), "v"(hi)); return r; }

__device__ __forceinline__ void mask_tile(f32x16& p0, f32x16& p1, int dq) {
    const float NEG = -__builtin_inff();
#pragma unroll
    for (int r = 0; r < 16; ++r) {
        const int c = (r & 3) + 8 * (r >> 2);
        if (dq - c < 0) p0[r] = NEG;
        if (dq - c - 32 < 0) p1[r] = NEG;
    }
}
template <int SCALE_NUM>
__device__ __forceinline__ void partialSM(f32x16& p0, f32x16& p1, float& m_reg, float& mn, float& alpha) {
    constexpr float SCALE = SCALE_NUM == 192 ? 0.07216878364870322f : 0.08838834764831845f;
    float pmax = p0[0];
#pragma unroll
    for (int r = 1; r < 16; ++r) pmax = fmaxf(pmax, p0[r]);
#pragma unroll
    for (int r = 0; r < 16; ++r) pmax = fmaxf(pmax, p1[r]);
    { auto rr = __builtin_amdgcn_permlane32_swap(__float_as_uint(pmax), __float_as_uint(pmax), false, false);
      pmax = fmaxf(__uint_as_float(rr[0]), __uint_as_float(rr[1])); }
    constexpr float C2 = 1.4426950408889634f * SCALE;
    if (__builtin_expect(__all((pmax - m_reg) * SCALE <= THR), 1)) { mn = m_reg; alpha = 1.f; }
    else { mn = fmaxf(m_reg, pmax); alpha = __builtin_amdgcn_exp2f((m_reg - mn) * C2); m_reg = mn; }
    const float mnL = -mn * C2;
#pragma unroll
    for (int r = 0; r < 16; ++r) p0[r] = fmaf(p0[r], C2, mnL);
#pragma unroll
    for (int r = 0; r < 16; ++r) p1[r] = fmaf(p1[r], C2, mnL);
#pragma unroll
    for (int r = 0; r < 16; ++r) p0[r] = __builtin_amdgcn_exp2f(p0[r]);
}
__device__ __forceinline__ void finishSM(f32x16& p0, f32x16& p1, float alpha, float& l_reg, bf16x8& pa0, bf16x8& pa1, bf16x8& pa2, bf16x8& pa3) {
#pragma unroll
    for (int r = 0; r < 16; ++r) p1[r] = __builtin_amdgcn_exp2f(p1[r]);
    float ps = 0;
#pragma unroll
    for (int r = 0; r < 16; ++r) ps += p0[r];
#pragma unroll
    for (int r = 0; r < 16; ++r) ps += p1[r];
    { auto rr = __builtin_amdgcn_permlane32_swap(__float_as_uint(ps), __float_as_uint(ps), false, false);
      ps = __uint_as_float(rr[0]) + __uint_as_float(rr[1]); }
    l_reg = l_reg * alpha + ps;
#define PK4(P, B_, OUT) do { unsigned a0 = cvtpk(P[B_+0], P[B_+1]), a1 = cvtpk(P[B_+2], P[B_+3]);                          \
        unsigned b0 = cvtpk(P[B_+4], P[B_+5]), b1 = cvtpk(P[B_+6], P[B_+7]);                                             \
        auto r0 = __builtin_amdgcn_permlane32_swap(a0, b0, false, false); auto r1 = __builtin_amdgcn_permlane32_swap(a1, b1, false, false); \
        u32x4 w = {r0[0], r1[0], r0[1], r1[1]}; OUT = *reinterpret_cast<bf16x8*>(&w); } while (0)
    PK4(p0, 0, pa0); PK4(p0, 8, pa1); PK4(p1, 0, pa2); PK4(p1, 8, pa3);
#undef PK4
}
template <int KB, bool ROPE>
__device__ __forceinline__ void qkt(f32x16& p0, f32x16& p1, const char* lds, int r32, int hi, const bf16x8* qr) {
    p0 = f32x16{}; p1 = f32x16{};
    const char* kb[4];
#pragma unroll
    for (int dd = 0; dd < 4; ++dd) kb[dd] = lds + OFF_K + KB * SHM_K + KSWZ(r32, (dd * 16 + hi * 8) * 2);
#pragma unroll
    for (int d0 = 0; d0 < 8; ++d0) { const char* a = kb[d0 & 3] + (d0 >> 2) * 128;
        bf16x8 b0 = *reinterpret_cast<const bf16x8*>(a);
        bf16x8 b1 = *reinterpret_cast<const bf16x8*>(a + 32 * 256);
        p0 = __builtin_amdgcn_mfma_f32_32x32x16_bf16(b0, qr[d0], p0, 0, 0, 0);
        p1 = __builtin_amdgcn_mfma_f32_32x32x16_bf16(b1, qr[d0], p1, 0, 0, 0); }
    if constexpr (ROPE) {
#pragma unroll
        for (int dd = 0; dd < 4; ++dd) { const char* a = lds + OFF_KR + KB * SHM_KR + KRSWZ(r32, (dd * 16 + hi * 8) * 2);
            bf16x8 b0 = *reinterpret_cast<const bf16x8*>(a);
            bf16x8 b1 = *reinterpret_cast<const bf16x8*>(a + 32 * 128);
            p0 = __builtin_amdgcn_mfma_f32_32x32x16_bf16(b0, qr[8 + dd], p0, 0, 0, 0);
            p1 = __builtin_amdgcn_mfma_f32_32x32x16_bf16(b1, qr[8 + dd], p1, 0, 0, 0); }
    }
}
template <int VB>
__device__ __forceinline__ void pv_tile(f32x16* o, int vb0, bf16x8 pa0, bf16x8 pa1, bf16x8 pa2, bf16x8 pa3) {
#define TRRD(dst, off) asm volatile("ds_read_b64_tr_b16 %0, %1 offset:%2" : "=&v"(dst) : "v"(vb0), "i"(off) : "memory")
#define PV_D0(d0) do { s16x4 l0, l1, l2, l3, h0, h1, h2, h3; constexpr int b_ = OFF_V + VB * SHM_V + v_rd_off(d0, 0, 0);  \
        TRRD(l0, b_); TRRD(h0, b_ + 2048); TRRD(l1, b_ + 4096); TRRD(h1, b_ + 6144); TRRD(l2, b_ + 8192); TRRD(h2, b_ + 10240); TRRD(l3, b_ + 12288); TRRD(h3, b_ + 14336); \
        asm volatile("s_waitcnt lgkmcnt(0)" ::: "memory"); SBAR();   \
        o[d0] = __builtin_amdgcn_mfma_f32_32x32x16_bf16(pa0, (bf16x8){l0[0], l0[1], l0[2], l0[3], h0[0], h0[1], h0[2], h0[3]}, o[d0], 0, 0, 0);   \
        o[d0] = __builtin_amdgcn_mfma_f32_32x32x16_bf16(pa1, (bf16x8){l1[0], l1[1], l1[2], l1[3], h1[0], h1[1], h1[2], h1[3]}, o[d0], 0, 0, 0);   \
        o[d0] = __builtin_amdgcn_mfma_f32_32x32x16_bf16(pa2, (bf16x8){l2[0], l2[1], l2[2], l2[3], h2[0], h2[1], h2[2], h2[3]}, o[d0], 0, 0, 0);   \
        o[d0] = __builtin_amdgcn_mfma_f32_32x32x16_bf16(pa3, (bf16x8){l3[0], l3[1], l3[2], l3[3], h3[0], h3[1], h3[2], h3[3]}, o[d0], 0, 0, 0); } while (0)
    PV_D0(0); PV_D0(1); PV_D0(2); PV_D0(3);
#undef PV_D0
#undef TRRD
}

struct Head {
    const bf16_t* Q; const bf16_t* K; const bf16_t* KR; const bf16_t* V; bf16_t* O;
    const float* cosT; const float* sinT;
    const bf16_t* KM;
};
struct Stage { bf16x8 k0, k1, v0, v1, kr; };

template <bool MOBA>
__device__ __forceinline__ void attn_block(const Head& T, int qb, char* lds) {
    constexpr bool ROPE = !MOBA;
    constexpr int QS = MOBA ? NMOBA : NQ, KS = MOBA ? NMOBA : NKV, VS = KS, KRS = NLAT, OS = 2 * DM;
    const int tid = tid_(), wid = __builtin_amdgcn_readfirstlane(tid >> 6), lane = tid & 63, r32 = lane & 31, hi = lane >> 5;
    const int NT = (qb + 1) * 4;
    const int P0 = qb * QB, qlo = P0 + wid * QBLK, qm = qlo + r32 - 4 * hi;
    float* ws = (float*)(lds + OFF_WS) + wid * 64; float* li_l = ws, * al_l = ws + 32;
    const int sr = tid >> 4, sc = (tid & 15) * 8, vst0 = v_st(sr, sc), vst1 = v_st(32 + sr, sc), kws = KSWZ(sr, sc * 2);
    const int rr_ = tid >> 3, rc_ = (tid & 7) * 8, krws = KRSWZ(rr_, rc_ * 2);
    const int vb0 = (int)(uintptr_t)lds + v_rd_base(lane);
    bf16x8 qr[ROPE ? 12 : 8];
    { const char* qbase = (const char*)T.Q + (size_t)(P0 + wid * QBLK) * QS * 2; const unsigned qoff = (unsigned)(r32 * QS + hi * 8) * 2u;
#pragma unroll
      for (int d0 = 0; d0 < (ROPE ? 12 : 8); ++d0) qr[d0] = *reinterpret_cast<const bf16x8*>(qbase + qoff + d0 * 32);
      if constexpr (ROPE) {
          const int pos = P0 + wid * QBLK + r32;
#pragma unroll
          for (int dd = 0; dd < 2; ++dd) {
              const f32x4 c0 = *(const f32x4*)(T.cosT + (size_t)pos * 32 + dd * 16 + hi * 8), c1 = *(const f32x4*)(T.cosT + (size_t)pos * 32 + dd * 16 + hi * 8 + 4);
              const f32x4 s0 = *(const f32x4*)(T.sinT + (size_t)pos * 32 + dd * 16 + hi * 8), s1 = *(const f32x4*)(T.sinT + (size_t)pos * 32 + dd * 16 + hi * 8 + 4);
              const u32x4 x1 = __builtin_bit_cast(u32x4, qr[8 + dd]), x2 = __builtin_bit_cast(u32x4, qr[10 + dd]);
              u32x4 y1, y2;
#pragma unroll
              for (int w = 0; w < 4; ++w) {
                  const float a_lo = bf_lo(x1[w]), a_hi = bf_hi(x1[w]), b_lo = bf_lo(x2[w]), b_hi = bf_hi(x2[w]);
                  const float cl = (w < 2 ? c0 : c1)[(2 * w) & 3], ch = (w < 2 ? c0 : c1)[(2 * w + 1) & 3];
                  const float sl = (w < 2 ? s0 : s1)[(2 * w) & 3], sh = (w < 2 ? s0 : s1)[(2 * w + 1) & 3];
                  y1[w] = pk2(a_lo * cl - b_lo * sl, a_hi * ch - b_hi * sh);
                  y2[w] = pk2(a_lo * sl + b_lo * cl, a_hi * sh + b_hi * ch);
              }
              qr[8 + dd] = __builtin_bit_cast(bf16x8, y1); qr[10 + dd] = __builtin_bit_cast(bf16x8, y2);
          }
      }
    }
    int sel0 = -1, sel1 = -1, sel2 = -1;
    if constexpr (MOBA) {
        f32x16 g = f32x16{};
        const unsigned kmoff = (unsigned)(r32 * 128 + hi * 8) * 2u;
#pragma unroll
        for (int d0 = 0; d0 < 8; ++d0) { const bf16x8 a = *reinterpret_cast<const bf16x8*>((const char*)T.KM + kmoff + d0 * 32); g = __builtin_amdgcn_mfma_f32_32x32x16_bf16(a, qr[d0], g, 0, 0, 0); }
        const float NEG = -__builtin_inff();
        float v0 = NEG, v1 = NEG, v2 = NEG;
#define INS3(x, bi) do { const float x_ = (x); const int b_ = (bi);                                                     \
            const bool g0 = (x_ > v0) || (x_ == v0 && x_ > NEG && b_ < sel0), g1 = (x_ > v1) || (x_ == v1 && x_ > NEG && b_ < sel1), g2 = (x_ > v2) || (x_ == v2 && x_ > NEG && b_ < sel2); \
            if (g0) { v2 = v1; sel2 = sel1; v1 = v0; sel1 = sel0; v0 = x_; sel0 = b_; }                                      \
            else if (g1) { v2 = v1; sel2 = sel1; v1 = x_; sel1 = b_; }                                                       \
            else if (g2) { v2 = x_; sel2 = b_; } } while (0)
#pragma unroll
        for (int r = 0; r < 16; ++r) { const int blk = crow(r, hi); const float x = blk < qb ? g[r] : NEG; INS3(x, blk); }
        const float pv0 = __shfl_xor(v0, 32), pv1 = __shfl_xor(v1, 32), pv2 = __shfl_xor(v2, 32);
        const int ps0 = __shfl_xor(sel0, 32), ps1 = __shfl_xor(sel1, 32), ps2 = __shfl_xor(sel2, 32);
        INS3(pv0, ps0); INS3(pv1, ps1); INS3(pv2, ps2);
#undef INS3
    }
    float m_reg = -1e30f, l_reg = 0; f32x16 o[4] = {};
    Stage S;
    const unsigned koff0 = (unsigned)(sr * KS + sc) * 2u, koff1 = (unsigned)((32 + sr) * KS + sc) * 2u, kroff = (unsigned)(rr_ * KRS + rc_) * 2u;
#define SLOAD(kp_) do { const char* kp__ = (const char*)T.K + (size_t)(kp_) * KS * 2; const char* vp__ = (const char*)T.V + (size_t)(kp_) * VS * 2;          \
                       S.v0 = *reinterpret_cast<const bf16x8*>(vp__ + koff0); S.v1 = *reinterpret_cast<const bf16x8*>(vp__ + koff1);   \
                       S.k0 = *reinterpret_cast<const bf16x8*>(kp__ + koff0); S.k1 = *reinterpret_cast<const bf16x8*>(kp__ + koff1);   \
                       if constexpr (ROPE) S.kr = *reinterpret_cast<const bf16x8*>((const char*)T.KR + (size_t)(kp_) * KRS * 2 + kroff); } while (0)
#define SWRITE(bf) do { *(bf16x8*)(lds + OFF_K + (bf) * SHM_K + kws) = S.k0; *(bf16x8*)(lds + OFF_K + (bf) * SHM_K + kws + 32 * 256) = S.k1;       \
                        *(bf16x8*)(lds + OFF_V + (bf) * SHM_V + vst0) = S.v0; *(bf16x8*)(lds + OFF_V + (bf) * SHM_V + vst1) = S.v1;                  \
                        if constexpr (ROPE) *(bf16x8*)(lds + OFF_KR + (bf) * SHM_KR + krws) = S.kr; } while (0)
#define RESC(a) do { if (__any((a) < 1.f)) { if (hi == 0) al_l[r32] = (a); asm volatile("s_waitcnt lgkmcnt(0)" ::: "memory");              \
                     _Pragma("unroll") for (int d_ = 0; d_ < 4; ++d_) _Pragma("unroll") for (int r = 0; r < 16; ++r) o[d_][r] *= al_l[crow(r, hi)]; } } while (0)
#define STEP(t, BF) do {                                                                                                     \
        const int kb_ = (t) * KVBLK; const bool more_ = (t) + 1 < NT;                                                        \
        if (more_) SLOAD(kb_ + KVBLK);                                                                                       \
        bool act_; bool keep_ = true;                                                                                        \
        if constexpr (MOBA) { const int j_ = (t) >> 2; if (j_ < qb) { keep_ = (j_ == sel0) || (j_ == sel1) || (j_ == sel2); act_ = __any(keep_); } else { act_ = kb_ <= qlo + QBLK - 1; } } \
        else { act_ = kb_ <= qlo + QBLK - 1; }                                                                               \
        if (act_) {                                                                                                          \
            f32x16 p0, p1; float mn, al; bf16x8 pa0, pa1, pa2, pa3;                                                          \
            SBAR(); qkt<BF, ROPE>(p0, p1, lds, r32, hi, qr); SBAR();                                                         \
            if (MOBA && ((t) >> 2) < qb) { if (!keep_) { const float NEG_ = -__builtin_inff(); _Pragma("unroll") for (int r = 0; r < 16; ++r) { p0[r] = NEG_; p1[r] = NEG_; } } } \
            else if (kb_ + KVBLK - 1 > qlo) mask_tile(p0, p1, qm - kb_);                                                     \
            partialSM<MOBA ? 128 : 192>(p0, p1, m_reg, mn, al);                                                              \
            RESC(al);                                                                                                        \
            finishSM(p0, p1, al, l_reg, pa0, pa1, pa2, pa3); SBAR();                                                         \
            pv_tile<BF>(o, vb0, pa0, pa1, pa2, pa3); SBAR();                                                                 \
        }                                                                                                                    \
        if (more_) { VM_WAIT(); SWRITE((BF) ^ 1); }                                                                          \
        __syncthreads(); } while (0)
    SLOAD(0); VM_WAIT(); SWRITE(0); __syncthreads();
    for (int t = 0; t < NT; t += 2) { STEP(t, 0); STEP(t + 1, 1); }
    if (hi == 0) li_l[r32] = l_reg; asm volatile("s_waitcnt lgkmcnt(0)" ::: "memory");
    float rli[16];
#pragma unroll
    for (int r = 0; r < 16; ++r) rli[r] = __builtin_amdgcn_rcpf(li_l[crow(r, hi)]);
    char* Ow = (char*)T.O + (size_t)(P0 + wid * QBLK) * OS * 2; const unsigned ooff = (unsigned)(4 * hi * OS + r32) * 2u;
#pragma unroll
    for (int r = 0; r < 16; ++r) { const int orow0 = (r & 3) + 8 * (r >> 2);
#pragma unroll
        for (int d0 = 0; d0 < 4; ++d0) { const float v = o[d0][r] * rli[r];
            const float vn = __shfl_xor(v, 1);
            if ((r32 & 1) == 0) *(unsigned*)(Ow + ooff + (orow0 * OS + d0 * 32) * 2) = cvtpk(v, vn); } }
    __syncthreads();
#undef SLOAD
#undef SWRITE
#undef RESC
#undef STEP
}

constexpr int MB_OACC = 65536, MB_OSTRIDE = 272;
constexpr int MB_ST = MB_OACC + 256 * MB_OSTRIDE;
constexpr int MB_CNT = MB_ST + 2048;
constexpr int MB_BL = MB_CNT + 128;
constexpr int MB_LIST = MB_BL + 512;
constexpr int MB_END = MB_LIST + 32 * 256;
static_assert(MB_END <= ::LDS_BYTES - 1024, "moba lds");
template <int VB>
__device__ __forceinline__ void pv_tileT(f32x16* o, int vb0, bf16x8 pa0, bf16x8 pa1, bf16x8 pa2, bf16x8 pa3) {
#define TRRD(dst, off) asm volatile("ds_read_b64_tr_b16 %0, %1 offset:%2" : "=&v"(dst) : "v"(vb0), "i"(off) : "memory")
#define PV_D0(d0) do { s16x4 l0, l1, l2, l3, h0, h1, h2, h3; constexpr int b_ = OFF_V + VB * SHM_V + v_rd_off(d0, 0, 0);  \
        TRRD(l0, b_); TRRD(h0, b_ + 2048); TRRD(l1, b_ + 4096); TRRD(h1, b_ + 6144); TRRD(l2, b_ + 8192); TRRD(h2, b_ + 10240); TRRD(l3, b_ + 12288); TRRD(h3, b_ + 14336); \
        asm volatile("s_waitcnt lgkmcnt(0)" ::: "memory"); SBAR();   \
        o[d0] = __builtin_amdgcn_mfma_f32_32x32x16_bf16((bf16x8){l0[0], l0[1], l0[2], l0[3], h0[0], h0[1], h0[2], h0[3]}, pa0, o[d0], 0, 0, 0);   \
        o[d0] = __builtin_amdgcn_mfma_f32_32x32x16_bf16((bf16x8){l1[0], l1[1], l1[2], l1[3], h1[0], h1[1], h1[2], h1[3]}, pa1, o[d0], 0, 0, 0);   \
        o[d0] = __builtin_amdgcn_mfma_f32_32x32x16_bf16((bf16x8){l2[0], l2[1], l2[2], l2[3], h2[0], h2[1], h2[2], h2[3]}, pa2, o[d0], 0, 0, 0);   \
        o[d0] = __builtin_amdgcn_mfma_f32_32x32x16_bf16((bf16x8){l3[0], l3[1], l3[2], l3[3], h3[0], h3[1], h3[2], h3[3]}, pa3, o[d0], 0, 0, 0); } while (0)
    PV_D0(0); PV_D0(1); PV_D0(2); PV_D0(3);
#undef PV_D0
#undef TRRD
}
#define MB_TRRD(dst, off) asm volatile("ds_read_b64_tr_b16 %0, %1 offset:%2" : "=&v"(dst) : "v"(vb0), "i"(off) : "memory")
struct VFr { s16x4 l0, l1, l2, l3, h0, h1, h2, h3; };
template <int VB, int D0> __device__ __forceinline__ void v_issue(VFr& f, int vb0) { constexpr int b_ = OFF_V + VB * SHM_V + v_rd_off(D0, 0, 0);
    MB_TRRD(f.l0, b_); MB_TRRD(f.h0, b_ + 2048); MB_TRRD(f.l1, b_ + 4096); MB_TRRD(f.h1, b_ + 6144); MB_TRRD(f.l2, b_ + 8192); MB_TRRD(f.h2, b_ + 10240); MB_TRRD(f.l3, b_ + 12288); MB_TRRD(f.h3, b_ + 14336); }
__device__ __forceinline__ void v_mma(f32x16& o, const VFr& f, bf16x8 pa0, bf16x8 pa1, bf16x8 pa2, bf16x8 pa3) {
    o = __builtin_amdgcn_mfma_f32_32x32x16_bf16((bf16x8){f.l0[0], f.l0[1], f.l0[2], f.l0[3], f.h0[0], f.h0[1], f.h0[2], f.h0[3]}, pa0, o, 0, 0, 0);
    o = __builtin_amdgcn_mfma_f32_32x32x16_bf16((bf16x8){f.l1[0], f.l1[1], f.l1[2], f.l1[3], f.h1[0], f.h1[1], f.h1[2], f.h1[3]}, pa1, o, 0, 0, 0);
    o = __builtin_amdgcn_mfma_f32_32x32x16_bf16((bf16x8){f.l2[0], f.l2[1], f.l2[2], f.l2[3], f.h2[0], f.h2[1], f.h2[2], f.h2[3]}, pa2, o, 0, 0, 0);
    o = __builtin_amdgcn_mfma_f32_32x32x16_bf16((bf16x8){f.l3[0], f.l3[1], f.l3[2], f.l3[3], f.h3[0], f.h3[1], f.h3[2], f.h3[3]}, pa3, o, 0, 0, 0); }
__device__ __forceinline__ void moba_block(const Head& T, int qb, char* lds) {
    constexpr int QS = NMOBA, KS = NMOBA, VS = NMOBA, OS = 2 * DM;
    constexpr float C2 = 1.4426950408889634f * 0.08838834764831845f;
    const int tid = tid_(), wid = __builtin_amdgcn_readfirstlane(tid >> 6), lane = tid & 63, r32 = lane & 31, hi = lane >> 5;
    const int P0 = qb * QB;
    int* cnt = (int*)(lds + MB_CNT); int* bl = (int*)(lds + MB_BL); unsigned char* list = (unsigned char*)(lds + MB_LIST);
    float* st = (float*)(lds + MB_ST);
    if (tid < 32) cnt[tid] = 0;
    if (tid < 256) { st[2 * tid] = -1e30f; st[2 * tid + 1] = 0.f; }
    __syncthreads();
    const char* qbase = (const char*)T.Q + (size_t)P0 * QS * 2;
    {
        bf16x8 qg[8];
        { const unsigned qoff = (unsigned)((wid * QBLK + r32) * QS + hi * 8) * 2u;
#pragma unroll
          for (int d0 = 0; d0 < 8; ++d0) qg[d0] = *reinterpret_cast<const bf16x8*>(qbase + qoff + d0 * 32); }
        int sel0 = -1, sel1 = -1, sel2 = -1;
        f32x16 g = f32x16{};
        const unsigned kmoff = (unsigned)(r32 * 128 + hi * 8) * 2u;
#pragma unroll
        for (int d0 = 0; d0 < 8; ++d0) { const bf16x8 a = *reinterpret_cast<const bf16x8*>((const char*)T.KM + kmoff + d0 * 32); g = __builtin_amdgcn_mfma_f32_32x32x16_bf16(a, qg[d0], g, 0, 0, 0); }
        const float NEG = -__builtin_inff();
        float v0 = NEG, v1 = NEG, v2 = NEG;
#define INS3(x, bi) do { const float x_ = (x); const int b_ = (bi);                                                     \
            const bool g0 = (x_ > v0) || (x_ == v0 && x_ > NEG && b_ < sel0), g1 = (x_ > v1) || (x_ == v1 && x_ > NEG && b_ < sel1), g2 = (x_ > v2) || (x_ == v2 && x_ > NEG && b_ < sel2); \
            if (g0) { v2 = v1; sel2 = sel1; v1 = v0; sel1 = sel0; v0 = x_; sel0 = b_; }                                      \
            else if (g1) { v2 = v1; sel2 = sel1; v1 = x_; sel1 = b_; }                                                       \
            else if (g2) { v2 = x_; sel2 = b_; } } while (0)
#pragma unroll
        for (int r = 0; r < 16; ++r) { const int blk = crow(r, hi); const float x = blk < qb ? g[r] : NEG; INS3(x, blk); }
        const float pv0 = __shfl_xor(v0, 32), pv1 = __shfl_xor(v1, 32), pv2 = __shfl_xor(v2, 32);
        const int ps0 = __shfl_xor(sel0, 32), ps1 = __shfl_xor(sel1, 32), ps2 = __shfl_xor(sel2, 32);
        INS3(pv0, ps0); INS3(pv1, ps1); INS3(pv2, ps2);
#undef INS3
        if (hi == 0) { const unsigned char row = (unsigned char)(wid * QBLK + r32);
            if (sel0 >= 0) { const int p = atomicAdd(cnt + sel0, 1); list[sel0 * 256 + p] = row; }
            if (sel1 >= 0) { const int p = atomicAdd(cnt + sel1, 1); list[sel1 * 256 + p] = row; }
            if (sel2 >= 0) { const int p = atomicAdd(cnt + sel2, 1); list[sel2 * 256 + p] = row; } }
    }
    __syncthreads();
    if (tid == 0) { int nr = 0; for (int j = 0; j < qb; ++j) { const int c = cnt[j]; if (c > 0) bl[nr++] = j; if (c > 128) bl[nr++] = j | 256; } bl[nr] = qb; bl[nr + 1] = qb | 256; bl[80] = nr; }
    __syncthreads();
    const int nr = __builtin_amdgcn_readfirstlane(bl[80]);
    const int NR = nr + 2, NT = 4 * NR;
#define KB_OF(t) ((__builtin_amdgcn_readfirstlane(bl[(t) >> 2]) & 255) * 256 + ((t) & 3) * KVBLK)
    if (wid >= 4) {
        const int lt = tid - 256;
        bf16x8 S0[8], S1[8], S2[8], S3[8];
        unsigned srck[4], dstk[4], dstv[4];
#pragma unroll
        for (int i = 0; i < 4; ++i) { const int c = lt + 256 * i, rw = c >> 4, cc = c & 15; srck[i] = (unsigned)(rw * KS + cc * 8) * 2u; dstk[i] = (unsigned)KSWZ(rw, cc * 16); dstv[i] = (unsigned)v_st(rw, cc * 8); }
#define LLOAD(SET, t) do { const int tt_ = (t) < NT ? (t) : NT - 1; const int kb_ = KB_OF(tt_);                             \
            const char* kp__ = (const char*)T.K + (size_t)kb_ * KS * 2; const char* vp__ = (const char*)T.V + (size_t)kb_ * VS * 2;   \
            _Pragma("unroll") for (int i = 0; i < 4; ++i) { SET[i] = *reinterpret_cast<const bf16x8*>(kp__ + srck[i]); SET[4 + i] = *reinterpret_cast<const bf16x8*>(vp__ + srck[i]); } } while (0)
#define LWRITE(SET, bf) do { _Pragma("unroll") for (int i = 0; i < 4; ++i) { *(bf16x8*)(lds + OFF_K + (bf) * SHM_K + dstk[i]) = SET[i]; *(bf16x8*)(lds + OFF_V + (bf) * SHM_V + dstv[i]) = SET[4 + i]; } } while (0)
        LLOAD(S0, 0); LLOAD(S1, 1); LLOAD(S2, 2); LLOAD(S3, 3);
        LWRITE(S0, 0); LLOAD(S0, 4);
        __syncthreads();
#pragma unroll 1
        for (int rnd = 0; rnd < NR; ++rnd) {
            const int t = 4 * rnd;
            LWRITE(S1, 1); LLOAD(S1, t + 5); __syncthreads();
            LWRITE(S2, 0); LLOAD(S2, t + 6); __syncthreads();
            LWRITE(S3, 1); LLOAD(S3, t + 7); __syncthreads();
            LWRITE(S0, 0); LLOAD(S0, t + 8); __syncthreads();
        }
#undef LLOAD
#undef LWRITE
    } else {
        const int vb0 = (int)(uintptr_t)lds + v_rd_base(lane);
#define ROUND_ROWS(rnd, rowv, validv, actv) do { const int e_ = __builtin_amdgcn_readfirstlane(bl[rnd]); const int j_ = e_ & 255, g_ = e_ >> 8;     \
            if ((rnd) >= nr) { rowv = 128 * g_ + wid * QBLK + r32; validv = true; actv = true; }                                 \
            else { const int c_ = __builtin_amdgcn_readfirstlane(cnt[j_]); const int tb_ = 4 * g_ + ((wid - j_) & 3);             \
                   actv = tb_ * 32 < c_; const int p_ = tb_ * 32 + r32; validv = p_ < c_; rowv = validv ? (int)list[j_ * 256 + p_] : 0; } } while (0)
        float m_reg = -1e30f, l_reg = 0.f; f32x16 o[4]; bf16x8 qr[8], qn[8];
        int row = 0; bool valid = false, act = false;
        int qlo = 0;
#define STEP(t, BF, OWN) do {                                                                                                \
            const int kb_ = P0 + ((t) & 3) * KVBLK;                                                      \
            bool act_ = act; if (OWN) act_ = kb_ <= qlo + QBLK - 1;                                                           \
            if (act_) {                                                                                                      \
                f32x16 p0, p1; float mn, al; bf16x8 pa0, pa1, pa2, pa3; VFr fa, fb;                                          \
                SBAR(); qkt<BF, false>(p0, p1, lds, r32, hi, qr); SBAR();                                                    \
                v_issue<BF, 0>(fa, vb0); v_issue<BF, 1>(fb, vb0);                                                            \
                if (OWN) { if (kb_ + KVBLK - 1 > qlo) mask_tile(p0, p1, qlo + r32 - 4 * hi - kb_); }                          \
                partialSM<128>(p0, p1, m_reg, mn, al);                                                                       \
                if (__any(al < 1.f)) { _Pragma("unroll") for (int d_ = 0; d_ < 4; ++d_) o[d_] = o[d_] * al; }                 \
                finishSM(p0, p1, al, l_reg, pa0, pa1, pa2, pa3);                                                             \
                asm volatile("s_waitcnt lgkmcnt(0)" ::: "memory"); SBAR();                                                   \
                v_mma(o[0], fa, pa0, pa1, pa2, pa3); v_issue<BF, 2>(fa, vb0); v_mma(o[1], fb, pa0, pa1, pa2, pa3); v_issue<BF, 3>(fb, vb0); \
                asm volatile("s_waitcnt lgkmcnt(0)" ::: "memory"); SBAR();                                                   \
                v_mma(o[2], fa, pa0, pa1, pa2, pa3); v_mma(o[3], fb, pa0, pa1, pa2, pa3); SBAR();                            \
            }                                                                                                                \
            __syncthreads(); } while (0)
#define MERGE(FINAL) do { if (valid) {                                                                                       \
            const float M_ = st[2 * row], W_ = st[2 * row + 1];                                                              \
            const float Mn = fmaxf(M_, m_reg), ea = __builtin_amdgcn_exp2f((M_ - Mn) * C2), eb = __builtin_amdgcn_exp2f((m_reg - Mn) * C2);   \
            const float a_ = ea * W_, b_ = eb * l_reg, Wn = a_ + b_, inv = __builtin_amdgcn_rcpf(Wn);                        \
            const float ca = W_ > 0.f ? a_ * inv : 0.f, cb = eb * inv;                                                       \
            char* orow = lds + MB_OACC + row * MB_OSTRIDE + hi * 8;                                                          \
            char* grow = (char*)T.O + (size_t)(P0 + row) * OS * 2 + hi * 8;                                                  \
            _Pragma("unroll") for (int d0 = 0; d0 < 4; ++d0) _Pragma("unroll") for (int g_ = 0; g_ < 4; ++g_) {              \
                u32x2 old = {0u, 0u}; if (W_ > 0.f) old = *(const u32x2*)(orow + (d0 * 32 + g_ * 8) * 2);                    \
                const float n0 = ca * bf_lo(old.x) + cb * o[d0][4 * g_ + 0], n1 = ca * bf_hi(old.x) + cb * o[d0][4 * g_ + 1]; \
                const float n2 = ca * bf_lo(old.y) + cb * o[d0][4 * g_ + 2], n3 = ca * bf_hi(old.y) + cb * o[d0][4 * g_ + 3]; \
                u32x2 nw; nw.x = cvtpk(n0, n1); nw.y = cvtpk(n2, n3);                                                        \
                if (FINAL) *(u32x2*)(grow + (d0 * 32 + g_ * 8) * 2) = nw; else *(u32x2*)(orow + (d0 * 32 + g_ * 8) * 2) = nw; } \
            asm volatile("s_waitcnt lgkmcnt(0)" ::: "memory");              \
            if (!(FINAL) && hi == 0) { st[2 * row] = Mn; st[2 * row + 1] = Wn; } } } while (0)
        int rown; bool validn, actn; ROUND_ROWS(0, rown, validn, actn);
        { const unsigned qoff = (unsigned)(rown * QS + hi * 8) * 2u;
#pragma unroll
          for (int d0 = 0; d0 < 8; ++d0) qn[d0] = *reinterpret_cast<const bf16x8*>(qbase + qoff + d0 * 32); }
        __syncthreads();
#pragma unroll 1
        for (int rnd = 0; rnd < NR; ++rnd) {
            const int t = 4 * rnd;
            row = rown; valid = validn; act = actn;
#pragma unroll
            for (int d0 = 0; d0 < 8; ++d0) qr[d0] = qn[d0];
            m_reg = -1e30f; l_reg = 0.f;
#pragma unroll
            for (int d_ = 0; d_ < 4; ++d_) o[d_] = f32x16{};
            if (rnd + 1 < NR) { ROUND_ROWS(rnd + 1, rown, validn, actn);
                const unsigned qoff = (unsigned)(rown * QS + hi * 8) * 2u;
#pragma unroll
                for (int d0 = 0; d0 < 8; ++d0) qn[d0] = *reinterpret_cast<const bf16x8*>(qbase + qoff + d0 * 32); }
            if (rnd < nr) { STEP(t, 0, false); STEP(t + 1, 1, false); STEP(t + 2, 0, false); STEP(t + 3, 1, false); if (act) MERGE(false); }
            else { qlo = P0 + 128 * (rnd - nr) + wid * QBLK; STEP(t, 0, true); STEP(t + 1, 1, true); STEP(t + 2, 0, true); STEP(t + 3, 1, true); MERGE(true); }
        }
#undef ROUND_ROWS
#undef STEP
#undef MERGE
    }
#undef KB_OF
    __syncthreads();
}
#undef KSWZ
#undef KRSWZ
#undef SBAR
}

typedef GAS unsigned gu32;
#define XB_TMO      128
#define XB_XCNT(j)  (256  + 64 * (j))
#define XB_XSUB(j)  (1280 + 64 * (j))
#define XB_XGEN(j)  (2304 + 64 * (j))
#define XB_TOP      3328
#define XB_TOPGEN   3392
#define XCD_BAR_WORDS 3456
#define XB_SPIN_CAP (1u << 18)
__device__ __forceinline__ unsigned xb_ld(unsigned* p)              { return __hip_atomic_load(p, __ATOMIC_RELAXED, __HIP_MEMORY_SCOPE_AGENT); }
__device__ __forceinline__ unsigned xb_add(unsigned* p, unsigned v) { return __hip_atomic_fetch_add(p, v, __ATOMIC_RELAXED, __HIP_MEMORY_SCOPE_AGENT); }
__device__ __forceinline__ unsigned xb_xcc_id() { return (unsigned)__builtin_amdgcn_s_getreg((3 << 11) | 20) & 0xFu; }
#define XB_SPIN(cond, bar) do { unsigned _sp = 0; while (cond) { __builtin_amdgcn_s_sleep(1); \
    if ((++_sp & 255u) == 0u) { if (xb_ld(&(bar)[XB_TMO])) break; if (_sp > XB_SPIN_CAP) { atomicAdd(&(bar)[XB_TMO], 1u); break; } } } } while (0)
struct XcdBarrier { unsigned* bar; unsigned x; volatile LAS unsigned* st; };
__device__ __forceinline__ XcdBarrier xcd_barrier_post(unsigned* bar, volatile LAS unsigned* st) {
    XcdBarrier b; b.bar = bar; b.x = xb_xcc_id(); b.st = st;
    if (threadIdx.x == 0) (void)xb_add(&bar[XB_XCNT(b.x)], 1u);
    return b;
}
__device__ __forceinline__ void xcd_barrier_complete(unsigned* bar, unsigned x, unsigned& nloc, unsigned& nx) {
    const unsigned G = gridDim.x * gridDim.y * gridDim.z;
    unsigned sum, cnt, mine, sp = 0u;
    for (;;) {
        sum = 0u; cnt = 0u; mine = 0u;
#pragma unroll
        for (unsigned j = 0; j < 16; ++j) { const unsigned c = xb_ld(&bar[XB_XCNT(j)]); sum += c; cnt += (c > 0u) ? 1u : 0u; mine = (j == x) ? c : mine; }
        if (sum == G) break;
        __builtin_amdgcn_s_sleep(1);
        if ((++sp & 255u) == 0u) { if (xb_ld(&bar[XB_TMO])) break; if (sp > XB_SPIN_CAP) { atomicAdd(&bar[XB_TMO], 1u); break; } }
    }
    nloc = mine > 0u ? mine : 1u; nx = cnt > 0u ? cnt : 1u;
}
__device__ __forceinline__ void xcd_barrier(const XcdBarrier& b) {
    asm volatile("s_waitcnt vmcnt(0)" ::: "memory");
    __syncthreads();
    if (threadIdx.x == 0) {
        unsigned* bar = b.bar;
        __builtin_amdgcn_s_waitcnt(0);
        unsigned nloc = b.st[0], nx = b.st[1];
        if (nloc == 0u) { xcd_barrier_complete(bar, b.x, nloc, nx); b.st[0] = nloc; b.st[1] = nx; }
        const unsigned old = xb_add(&bar[XB_XSUB(b.x)], 1u);
        const unsigned gen = old / nloc;
        if (old + 1u == (gen + 1u) * nloc) {
            __builtin_amdgcn_fence(__ATOMIC_RELEASE, "agent");
            asm volatile("s_waitcnt vmcnt(0)" ::: "memory");
            const unsigned og = xb_add(&bar[XB_TOP], 1u);
            const unsigned tg = og / nx;
            if (og + 1u == (tg + 1u) * nx) xb_add(&bar[XB_TOPGEN], 1u);
            else XB_SPIN(xb_ld(&bar[XB_TOPGEN]) == tg, bar);
            __builtin_amdgcn_fence(__ATOMIC_ACQUIRE, "agent");
            xb_add(&bar[XB_XGEN(b.x)], 1u);
            asm volatile("s_waitcnt vmcnt(0)" ::: "memory");
        } else {
            XB_SPIN(xb_ld(&bar[XB_XGEN(b.x)]) == gen, bar);
            __builtin_amdgcn_fence(__ATOMIC_ACQUIRE, "agent");
            asm volatile("s_waitcnt vmcnt(0)" ::: "memory");
        }
    }
    __syncthreads();
}

struct Frame {
    LAS unsigned char* lds;
    volatile LAS unsigned* MISC;
    gu32* ctl;
    int vcu, G;
    unsigned char* ws;
    float* out;
};
__device__ __forceinline__ const float* ldp(const Frame& F, int k) {
    volatile LAS unsigned* p = F.MISC + 32 + 2 * k; unsigned lo = p[0], hi = p[1];
    lo = __builtin_amdgcn_readfirstlane(lo); hi = __builtin_amdgcn_readfirstlane(hi);
    return (const float*)(const GAS float*)(((unsigned long long)hi << 32) | (unsigned long long)lo);
}
__device__ __forceinline__ void unpack8(const u32x4 w, float* f) {
    f[0] = bf_lo(w.x); f[1] = bf_hi(w.x); f[2] = bf_lo(w.y); f[3] = bf_hi(w.y); f[4] = bf_lo(w.z); f[5] = bf_hi(w.z); f[6] = bf_lo(w.w); f[7] = bf_hi(w.w);
}
__device__ __forceinline__ u32x4 pack8f(const float* f) { u32x4 w; w.x = pk2(f[0], f[1]); w.y = pk2(f[2], f[3]); w.z = pk2(f[4], f[5]); w.w = pk2(f[6], f[7]); return w; }

__device__ __forceinline__ void p0_transpose_item(const float* W, int K, int N, bf16_t* WT, int row_off, LAS float* scr, int item, int lane, int ldw = 0, int col_off = 0) {
    if (ldw == 0) ldw = K;
    const int nblk = N / 32, kb = item / nblk, nb = item % nblk, k0 = 64 * kb, n0 = 32 * nb;
#pragma unroll 8
    for (int i = 0; i < 32; ++i) { const int kk = 2 * i + (lane >> 5); scr[kk * 33 + (lane & 31)] = W[(size_t)(k0 + kk) * N + n0 + (lane & 31)]; }
    LDS_WAIT(); asm volatile("" ::: "memory");
    const int c = lane & 7;
#pragma unroll
    for (int j = 0; j < 4; ++j) { const int n = (lane >> 3) + 8 * j; const LAS float* s = scr + (8 * c) * 33 + n;
        u32x4 o; o.x = pk2(s[0 * 33], s[1 * 33]); o.y = pk2(s[2 * 33], s[3 * 33]); o.z = pk2(s[4 * 33], s[5 * 33]); o.w = pk2(s[6 * 33], s[7 * 33]);
        *(GAS u32x4*)(WT + (size_t)(row_off + n0 + n) * ldw + col_off + k0 + 8 * c) = o; }
    LDS_WAIT(); asm volatile("" ::: "memory");
}
__device__ __forceinline__ void rms_row_to_bf16(int lane, const float* xrow, const float* g, bf16_t* orow) {
    const f32x4* xr = (const f32x4*)xrow + lane; const f32x4* gr = (const f32x4*)g + lane;
    f32x4 v[4]; float s = 0.f;
#pragma unroll
    for (int j = 0; j < 4; ++j) { v[j] = xr[64 * j]; s += (v[j].x * v[j].x + v[j].y * v[j].y) + (v[j].z * v[j].z + v[j].w * v[j].w); }
    const float rstd = 1.f / sqrtf(wave_sum(s) * (1.f / DM) + EPS);
    unsigned long long* o8 = (unsigned long long*)orow + lane;
#pragma unroll
    for (int j = 0; j < 4; ++j) { const f32x4 gg = gr[64 * j];
        o8[64 * j] = (unsigned long long)pk2(v[j].x * rstd * gg.x, v[j].y * rstd * gg.y) | ((unsigned long long)pk2(v[j].z * rstd * gg.z, v[j].w * rstd * gg.w) << 32); }
}
__device__ __forceinline__ void rms_row_f32(int lane, const float* xrow, const float* g, float* orow) {
    const f32x4* xr = (const f32x4*)xrow + lane; const f32x4* gr = (const f32x4*)g + lane;
    f32x4 v[4]; float s = 0.f;
#pragma unroll
    for (int j = 0; j < 4; ++j) { v[j] = xr[64 * j]; s += (v[j].x * v[j].x + v[j].y * v[j].y) + (v[j].z * v[j].z + v[j].w * v[j].w); }
    const float rstd = 1.f / sqrtf(wave_sum(s) * (1.f / DM) + EPS);
    f32x4* o = (f32x4*)orow + lane;
#pragma unroll
    for (int j = 0; j < 4; ++j) o[64 * j] = v[j] * rstd * gr[64 * j];
}

__device__ __forceinline__ void p0_prologue(Frame& F) {
    const int tid = tid_(), lane = tid & 63, wave = __builtin_amdgcn_readfirstlane(tid >> 6);
    LAS float* scr = (LAS float*)(F.lds + wave * 16384);
    const int gw = F.vcu * NWAVES + wave, NGW = F.G * NWAVES;
    const float* w_in = ldp(F, 2); const float* w_uq = ldp(F, 5); const float* w_ukv = ldp(F, 7); const float* w_oa = ldp(F, 8); const float* w_ob = ldp(F, 9);
    const float* w_out = ldp(F, 10); const float* w_up = ldp(F, 12); const float* w_dn = ldp(F, 15);
    bf16_t* Win = (bf16_t*)(F.ws + WS_WIN); bf16_t* Wuq = (bf16_t*)(F.ws + WS_WUQ); bf16_t* Wukv = (bf16_t*)(F.ws + WS_WUKV); bf16_t* Woa = (bf16_t*)(F.ws + WS_WOA);
    bf16_t* Wob = (bf16_t*)(F.ws + WS_WOB); bf16_t* Wout = (bf16_t*)(F.ws + WS_WOUT); bf16_t* Wup = (bf16_t*)(F.ws + WS_WUP); bf16_t* Wdn = (bf16_t*)(F.ws + WS_WDN);
    constexpr int NIN0 = 5824;
    constexpr int I_IN = (DM / 64) * (NIN0 / 32), I_UQ = (QL / 64) * (NQ / 32), I_UKV = (KVL / 64) * (NKV / 32), I_O = (DM / 64) * (DM / 32), I_UP = (DM / 64) * (NUP / 32), I_DN = (DFF / 64) * (DM / 32);
    constexpr int NITEMS = I_IN + I_UQ + I_UKV + 3 * I_O + I_UP + I_DN;
    for (int it = gw; it < NITEMS; it += NGW) {
        int r = it;
        if (r < I_IN) { const int nb = r % (NIN0 / 32); p0_transpose_item(w_in, DM, NIN0, Win, (nb * 32 >= 704) ? 64 : 0, scr, r, lane); continue; } r -= I_IN;
        if (r < I_UQ) { p0_transpose_item(w_uq, QL, NQ, Wuq, 0, scr, r, lane); continue; } r -= I_UQ;
        if (r < I_UKV) { p0_transpose_item(w_ukv, KVL, NKV, Wukv, 0, scr, r, lane); continue; } r -= I_UKV;
        if (r < I_O) { p0_transpose_item(w_oa, DM, DM, Woa, 0, scr, r, lane, 2 * DM, 0); continue; } r -= I_O;
        if (r < I_O) { p0_transpose_item(w_ob, DM, DM, Woa, 0, scr, r, lane, 2 * DM, DM); continue; } r -= I_O;
        if (r < I_O) { p0_transpose_item(w_out, DM, DM, Wout, 0, scr, r, lane); continue; } r -= I_O;
        if (r < I_UP) { const int n0 = (r % (NUP / 32)) * 32, half = n0 >= DFF ? 1 : 0, nn = n0 - half * DFF;
            p0_transpose_item(w_up, DM, NUP, Wup, 256 * (nn / 128) + 128 * half + (nn % 128) - n0, scr, r, lane); continue; } r -= I_UP;
        p0_transpose_item(w_dn, DFF, DM, Wdn, 0, scr, r, lane);
    }
    const int gt = F.vcu * (NWAVES * 64) + tid, NGT = F.G * NWAVES * 64;
    for (int i = gt; i < 64 * DM / 8; i += NGT) *(GAS u32x4*)(Win + (size_t)704 * DM + (size_t)i * 8) = (u32x4){0u, 0u, 0u, 0u};
    float* csb = (float*)(F.ws + WS_CSB); float* csa = (float*)(F.ws + WS_CSA);
    for (int i = gt; i < SEQ * 64; i += NGT) { const int pos = i >> 6, k = i & 63; const float inv = powf(10000.0f, -(float)k / 64.0f); const float ang = (float)pos * inv;
        csb[i] = cosf(ang); csb[SEQ * 64 + i] = sinf(ang); }
    for (int i = gt; i < SEQ * 32; i += NGT) { const int pos = i >> 5, k = i & 31; const float inv = powf(10000.0f, -(float)k / 32.0f); const float ang = (float)pos * inv;
        csa[i] = cosf(ang); csa[SEQ * 32 + i] = sinf(ang); }
    bf16_t* XN = (bf16_t*)(F.ws + WS_XN);
    { const float* x_ = ldp(F, 0); const float* g_ = ldp(F, 1);
      for (int m = gw; m < M; m += NGW) rms_row_to_bf16(lane, x_ + (size_t)m * DM, g_, XN + (size_t)m * DM); }
}

__device__ __forceinline__ void rope8(const u32x4 x1, const u32x4 x2, const float* cs, const float* sn, u32x4& y1, u32x4& y2, float* acc1, float* acc2) {
    float a[8], b[8], o1[8], o2[8]; unpack8(x1, a); unpack8(x2, b);
    const f32x4 c0 = *(const f32x4*)cs, c1 = *(const f32x4*)(cs + 4), s0 = *(const f32x4*)sn, s1 = *(const f32x4*)(sn + 4);
#pragma unroll
    for (int j = 0; j < 8; ++j) { const float c = j < 4 ? c0[j & 3] : c1[j & 3], s = j < 4 ? s0[j & 3] : s1[j & 3]; o1[j] = a[j] * c - b[j] * s; o2[j] = a[j] * s + b[j] * c; }
    y1 = pack8f(o1); y2 = pack8f(o2);
    if (acc1) {
        float r1[8], r2[8]; unpack8(y1, r1); unpack8(y2, r2);
#pragma unroll
        for (int j = 0; j < 8; ++j) { acc1[j] += r1[j]; acc2[j] += r2[j]; }
    }
}
__device__ __forceinline__ void p1e_phase(Frame& F) {
    bf16_t* LAT = (bf16_t*)(F.ws + WS_LAT); bf16_t* MQKV = (bf16_t*)(F.ws + WS_MQKV); bf16_t* KM = (bf16_t*)(F.ws + WS_KM);
    const float* csb = (const float*)(F.ws + WS_CSB); const float* csa = (const float*)(F.ws + WS_CSA);
    const float* g_q = ldp(F, 4); const float* g_kv = ldp(F, 6);
    const int tid = tid_(), lane = tid & 63, wave = __builtin_amdgcn_readfirstlane(tid >> 6);
    for (int u = F.vcu; u < 256; u += F.G) {
        const int rb = u >> 2, cg = u & 3, m0 = rb * 256, pos0 = (rb & 31) * 256, b = rb >> 5, blk = rb & 31;
        if (cg == 0) {
            float gq[8], gk[8];
#pragma unroll
            for (int j = 0; j < 8; ++j) { gq[j] = lane < 48 ? g_q[8 * lane + j] : 0.f; gk[j] = lane < 32 ? g_kv[8 * lane + j] : 0.f; }
            for (int it = 0; it < 32; it += 4) {
                u32x4 a[4], k[4], c1[4], c2[4];
#pragma unroll
                for (int q = 0; q < 4; ++q) { bf16_t* row = LAT + (size_t)(m0 + wave * 32 + it + q) * NLAT;
                    a[q] = lane < 48 ? *(const u32x4*)(row + 8 * lane) : (u32x4){0u, 0u, 0u, 0u};
                    k[q] = lane < 32 ? *(const u32x4*)(row + QL + 8 * lane) : (u32x4){0u, 0u, 0u, 0u};
                    if (lane < 4) { c1[q] = *(const u32x4*)(row + QL + KVL + 8 * lane); c2[q] = *(const u32x4*)(row + QL + KVL + 32 + 8 * lane); } }
#pragma unroll
                for (int q = 0; q < 4; ++q) { bf16_t* row = LAT + (size_t)(m0 + wave * 32 + it + q) * NLAT; const int pos = pos0 + wave * 32 + it + q;
                    float fa[8], fk[8]; unpack8(a[q], fa); unpack8(k[q], fk);
                    float sa = 0.f, sk = 0.f;
#pragma unroll
                    for (int j = 0; j < 8; ++j) { sa += fa[j] * fa[j]; sk += fk[j] * fk[j]; }
                    const float ra = 1.f / sqrtf(wave_sum(sa) * (1.f / QL) + EPS), rk = 1.f / sqrtf(wave_sum(sk) * (1.f / KVL) + EPS);
#pragma unroll
                    for (int j = 0; j < 8; ++j) { fa[j] *= ra * gq[j]; fk[j] *= rk * gk[j]; }
                    if (lane < 48) *(u32x4*)(row + 8 * lane) = pack8f(fa);
                    if (lane < 32) *(u32x4*)(row + QL + 8 * lane) = pack8f(fk);
                    if (lane < 4) { u32x4 y1, y2; rope8(c1[q], c2[q], csa + (size_t)pos * 32 + 8 * lane, csa + (size_t)SEQ * 32 + (size_t)pos * 32 + 8 * lane, y1, y2, nullptr, nullptr);
                        *(u32x4*)(row + QL + KVL + 8 * lane) = y1; *(u32x4*)(row + QL + KVL + 32 + 8 * lane) = y2; } }
            }
        } else if (cg == 1) {
            const int head = lane >> 3, c = lane & 7;
            for (int it = 0; it < 32; it += 4) {
                u32x4 x1[4], x2[4];
#pragma unroll
                for (int q = 0; q < 4; ++q) { const bf16_t* p = MQKV + (size_t)(m0 + wave * 32 + it + q) * NMOBA + head * 128 + 8 * c; x1[q] = *(const u32x4*)p; x2[q] = *(const u32x4*)(p + 64); }
#pragma unroll
                for (int q = 0; q < 4; ++q) { bf16_t* p = MQKV + (size_t)(m0 + wave * 32 + it + q) * NMOBA + head * 128 + 8 * c; const int pos = pos0 + wave * 32 + it + q;
                    u32x4 y1, y2; rope8(x1[q], x2[q], csb + (size_t)pos * 64 + 8 * c, csb + (size_t)SEQ * 64 + (size_t)pos * 64 + 8 * c, y1, y2, nullptr, nullptr);
                    *(u32x4*)p = y1; *(u32x4*)(p + 64) = y2; }
            }
        } else {
            const int rsub = lane >> 5, head = 4 * (cg - 2) + ((lane >> 3) & 3), c = lane & 7;
            float s1[8], s2[8];
#pragma unroll
            for (int j = 0; j < 8; ++j) { s1[j] = 0.f; s2[j] = 0.f; }
            for (int it = 0; it < 16; it += 4) {
                u32x4 x1[4], x2[4];
#pragma unroll
                for (int q = 0; q < 4; ++q) { const bf16_t* p = MQKV + (size_t)(m0 + wave * 32 + 2 * (it + q) + rsub) * NMOBA + 1024 + head * 128 + 8 * c; x1[q] = *(const u32x4*)p; x2[q] = *(const u32x4*)(p + 64); }
#pragma unroll
                for (int q = 0; q < 4; ++q) { bf16_t* p = MQKV + (size_t)(m0 + wave * 32 + 2 * (it + q) + rsub) * NMOBA + 1024 + head * 128 + 8 * c; const int pos = pos0 + wave * 32 + 2 * (it + q) + rsub;
                    u32x4 y1, y2; rope8(x1[q], x2[q], csb + (size_t)pos * 64 + 8 * c, csb + (size_t)SEQ * 64 + (size_t)pos * 64 + 8 * c, y1, y2, s1, s2);
                    *(u32x4*)p = y1; *(u32x4*)(p + 64) = y2; }
            }
            LAS float* part = (LAS float*)F.lds;
#pragma unroll
            for (int j = 0; j < 8; ++j) { s1[j] += __shfl_xor(s1[j], 32); s2[j] += __shfl_xor(s2[j], 32); }
            if (lane < 32) {
#pragma unroll
                for (int j = 0; j < 8; ++j) { part[(wave * 32 + lane) * 16 + j] = s1[j]; part[(wave * 32 + lane) * 16 + 8 + j] = s2[j]; } }
            LDS_WAIT(); __syncthreads();
            { const int l2 = tid >> 4, v = tid & 15; float s = 0.f;
#pragma unroll
              for (int w = 0; w < 8; ++w) s += part[(w * 32 + l2) * 16 + v];
              const int hd = 4 * (cg - 2) + (l2 >> 3), cc = l2 & 7, dim = v < 8 ? 8 * cc + v : 64 + 8 * cc + (v - 8);
              KM[((size_t)(b * 8 + hd) * 32 + blk) * 128 + dim] = (bf16_t)f2bf(s * (1.f / 256.f)); }
            LDS_WAIT(); __syncthreads();
        }
    }
}

__device__ __forceinline__ void p4e_phase(Frame& F, int b) {
    const bf16_t* G = (const bf16_t*)(F.ws + WS_G); bf16_t* ACT = (bf16_t*)(F.ws + WS_ACT) + (size_t)b * SEQ * DFF;
    const float* cw = ldp(F, 13); const float* cb = ldp(F, 14);
    const int gt = F.vcu * (NWAVES * 64) + tid_(), NGT = F.G * NWAVES * 64;
    constexpr int NCH = DFF / 8, RG = 8, NTASK = (SEQ / RG) * NCH;
    for (int task = gt; task < NTASK; task += NGT) {
        const int rg = task / NCH, ch = task - rg * NCH, c = ch * 8, r0 = rg * RG;
        float w0a[8], w1a[8], w2a[8], ba[8], w0b[8], w1b[8], w2b[8], bb[8];
#pragma unroll
        for (int j = 0; j < 8; ++j) { w0a[j] = cw[c + j]; w1a[j] = cw[NUP + c + j]; w2a[j] = cw[2 * NUP + c + j]; ba[j] = cb[c + j];
            w0b[j] = cw[DFF + c + j]; w1b[j] = cw[NUP + DFF + c + j]; w2b[j] = cw[2 * NUP + DFF + c + j]; bb[j] = cb[DFF + c + j]; }
        float p2a[8], p1a[8], p2b[8], p1b[8];
        { u32x4 z = {0u, 0u, 0u, 0u};
          const u32x4 t2a = r0 >= 2 ? *(const u32x4*)(G + (size_t)(r0 - 2) * NUP + c) : z, t2b = r0 >= 2 ? *(const u32x4*)(G + (size_t)(r0 - 2) * NUP + DFF + c) : z;
          const u32x4 t1a = r0 >= 1 ? *(const u32x4*)(G + (size_t)(r0 - 1) * NUP + c) : z, t1b = r0 >= 1 ? *(const u32x4*)(G + (size_t)(r0 - 1) * NUP + DFF + c) : z;
          unpack8(t2a, p2a); unpack8(t2b, p2b); unpack8(t1a, p1a); unpack8(t1b, p1b); }
        u32x4 ca[RG], cbv[RG];
#pragma unroll
        for (int r = 0; r < RG; ++r) { ca[r] = *(const u32x4*)(G + (size_t)(r0 + r) * NUP + c); cbv[r] = *(const u32x4*)(G + (size_t)(r0 + r) * NUP + DFF + c); }
#pragma unroll
        for (int r = 0; r < RG; ++r) {
            float xa[8], xb[8], o[8]; unpack8(ca[r], xa); unpack8(cbv[r], xb);
#pragma unroll
            for (int j = 0; j < 8; ++j) {
                const float u1 = ba[j] + w0a[j] * p2a[j] + w1a[j] * p1a[j] + w2a[j] * xa[j];
                const float u2 = bb[j] + w0b[j] * p2b[j] + w1b[j] * p1b[j] + w2b[j] * xb[j];
                o[j] = u1 * sigmoidf_(u1) * u2;
                p2a[j] = p1a[j]; p1a[j] = xa[j]; p2b[j] = p1b[j]; p1b[j] = xb[j];
            }
            *(u32x4*)(ACT + (size_t)(r0 + r) * DFF + c) = pack8f(o);
        }
    }
}


#ifndef DIAG
#define DIAG 0
#endif
constexpr int CW_DIAG = 2;
#if DIAG
__device__ __forceinline__ float bf2f(bf16_t v) { return __builtin_bit_cast(float, (unsigned)v << 16); }
__device__ __forceinline__ float rbf(float v) { return __builtin_bit_cast(float, f2bf(v) << 16); }
__device__ __forceinline__ void diag_flag(Frame& F, unsigned bit) { __hip_atomic_fetch_or((unsigned*)(F.ctl + CW_DIAG), bit, __ATOMIC_RELAXED, __HIP_MEMORY_SCOPE_AGENT); }
__device__ __forceinline__ unsigned hsh(unsigned x) { x ^= x >> 16; x *= 0x7feb352du; x ^= x >> 15; x *= 0x846ca68bu; x ^= x >> 16; return x; }
__device__ __forceinline__ void diag_rope_kmean(Frame& F) {
    const bf16_t* XN = (const bf16_t*)(F.ws + WS_XN); const bf16_t* Win = (const bf16_t*)(F.ws + WS_WIN);
    const bf16_t* LAT = (const bf16_t*)(F.ws + WS_LAT); const bf16_t* MQKV = (const bf16_t*)(F.ws + WS_MQKV); const bf16_t* KM = (const bf16_t*)(F.ws + WS_KM);
    const int gt = blockIdx.x * 512 + threadIdx.x, NGT = gridDim.x * 512;
    constexpr int NS = 48, PER = 8 * 2 * 64 + 32;
    for (int task = gt; task < NS * PER; task += NGT) {
        const int smp = task / PER, r = task - smp * PER; const int m = (int)(hsh(smp * 7919u + 13u) % (unsigned)M), pos = m & (SEQ - 1);
        int n1, n2; float inv; const bf16_t* got1; const bf16_t* got2;
        if (r < 1024) { const int which = r >> 9, h = (r >> 6) & 7, d = r & 63; n1 = NLAT + which * 1024 + h * 128 + d; n2 = n1 + 64; inv = powf(10000.0f, -(float)d / 64.0f);
            got1 = MQKV + (size_t)m * NMOBA + which * 1024 + h * 128 + d; got2 = got1 + 64; }
        else { const int d = r - 1024; n1 = QL + KVL + d; n2 = n1 + 32; inv = powf(10000.0f, -(float)d / 32.0f); got1 = LAT + (size_t)m * NLAT + n1; got2 = got1 + 32; }
        float x1 = 0.f, x2 = 0.f;
        for (int k = 0; k < DM; ++k) { const float a = bf2f(XN[(size_t)m * DM + k]); x1 += a * bf2f(Win[(size_t)n1 * DM + k]); x2 += a * bf2f(Win[(size_t)n2 * DM + k]); }
        x1 = rbf(x1); x2 = rbf(x2);
        const float ang = (float)pos * inv, c = cosf(ang), sn = sinf(ang);
        const float y1 = x1 * c - x2 * sn, y2 = x1 * sn + x2 * c, tol = 0.02f * (fabsf(x1) + fabsf(x2)) + 0.02f;
        if (!(fabsf(bf2f(*got1) - y1) <= tol) || !(fabsf(bf2f(*got2) - y2) <= tol)) diag_flag(F, 1u);
    }
    for (int task = gt; task < 16 * 32 * 128; task += NGT) {
        const int bh = task >> 12, blk = (task >> 7) & 31, d = task & 127, b = bh >> 3, h = bh & 7;
        float s = 0.f;
        for (int rr = 0; rr < 256; ++rr) s += bf2f(MQKV[(size_t)(b * SEQ + blk * 256 + rr) * NMOBA + 1024 + h * 128 + d]);
        s *= (1.f / 256.f);
        if (!(fabsf(bf2f(KM[task]) - s) <= 0.01f * fabsf(s) + 2e-3f)) diag_flag(F, 8u);
    }
}
template <bool MOBA>
__device__ __forceinline__ void diag_attn(Frame& F) {
    LAS float* sc = (LAS float*)F.lds;
    LAS float* qv = sc + 8192;
    LAS float* red = qv + 192;
    LAS float* misc = red + 512;
    const int tid = threadIdx.x;
    constexpr int NS = 96;
    for (int smp = blockIdx.x; smp < NS; smp += gridDim.x) {
        const unsigned hv = hsh(smp * 104729u + (MOBA ? 77u : 5u));
        const int bh = hv & 15, b = bh >> 3, h = bh & 7; int t = (hv >> 4) % SEQ; if (smp < 8) t = (smp & 1) ? 256 * (smp >> 1) + 255 : 256 * (smp >> 1);
        const int qb = t >> 8;
        __syncthreads();
        if (MOBA) { if (tid < 128) qv[tid] = bf2f(((const bf16_t*)(F.ws + WS_MQKV))[(size_t)(b * SEQ + t) * NMOBA + h * 128 + tid]); }
        else { if (tid < 192) { const bf16_t* q = (const bf16_t*)(F.ws + WS_Q) + (size_t)(b * SEQ + t) * NQ + h * 192; float v = bf2f(q[tid]);
                   if (tid >= 128) { const int d = tid - 128, i = d & 31; const float ang = (float)t * powf(10000.0f, -(float)i / 32.0f), c = cosf(ang), sn = sinf(ang);
                       const float x1 = bf2f(q[128 + i]), x2 = bf2f(q[160 + i]); v = d < 32 ? x1 * c - x2 * sn : x1 * sn + x2 * c; v = rbf(v); }
                   qv[tid] = v; } }
        __syncthreads();
        int sel0 = -1, sel1 = -1, sel2 = -1;
        if (MOBA) {
            if (tid < 32) { float g = -__builtin_inff(); if (tid < qb) { g = 0.f; const bf16_t* km = (const bf16_t*)(F.ws + WS_KM) + ((size_t)bh * 32 + tid) * 128; for (int d = 0; d < 128; ++d) g += qv[d] * bf2f(km[d]); } misc[tid] = g; }
            __syncthreads();
            if (tid == 0) { int s0 = -1, s1 = -1, s2 = -1; float v0 = -__builtin_inff(), v1 = v0, v2 = v0;
                for (int j = 0; j < 32; ++j) { const float x = misc[j]; if (x > v0) { v2 = v1; s2 = s1; v1 = v0; s1 = s0; v0 = x; s0 = j; } else if (x > v1) { v2 = v1; s2 = s1; v1 = x; s1 = j; } else if (x > v2) { v2 = x; s2 = j; } }
                misc[32] = (float)s0; misc[33] = (float)s1; misc[34] = (float)s2; }
            __syncthreads();
            sel0 = (int)misc[32]; sel1 = (int)misc[33]; sel2 = (int)misc[34];
        }
        const float scale = MOBA ? 0.08838834764831845f : 0.07216878364870322f;
        float lmax = -__builtin_inff();
        for (int key = tid; key <= t; key += 512) {
            float s = -__builtin_inff(); const int kblk = key >> 8;
            const bool use = MOBA ? (kblk == qb || kblk == sel0 || kblk == sel1 || kblk == sel2) : true;
            if (use) { s = 0.f;
                if (MOBA) { const bf16_t* k = (const bf16_t*)(F.ws + WS_MQKV) + (size_t)(b * SEQ + key) * NMOBA + 1024 + h * 128; for (int d = 0; d < 128; ++d) s += qv[d] * bf2f(k[d]); }
                else { const bf16_t* k = (const bf16_t*)(F.ws + WS_KV) + (size_t)(b * SEQ + key) * NKV + h * 256; for (int d = 0; d < 128; ++d) s += qv[d] * bf2f(k[d]);
                       const bf16_t* kr = (const bf16_t*)(F.ws + WS_LAT) + (size_t)(b * SEQ + key) * NLAT + QL + KVL; for (int d = 0; d < 64; ++d) s += qv[128 + d] * bf2f(kr[d]); }
                s *= scale; }
            sc[key] = s; lmax = fmaxf(lmax, s);
        }
        red[tid] = lmax; __syncthreads();
        for (int o = 256; o > 0; o >>= 1) { if (tid < o) red[tid] = fmaxf(red[tid], red[tid + o]); __syncthreads(); }
        const float mx = red[0]; __syncthreads();
        float lsum = 0.f;
        for (int key = tid; key <= t; key += 512) { const float p = __expf(sc[key] - mx); sc[key] = p; lsum += p; }
        red[tid] = lsum; __syncthreads();
        for (int o = 256; o > 0; o >>= 1) { if (tid < o) red[tid] += red[tid + o]; __syncthreads(); }
        const float ltot = red[0]; __syncthreads();
        const int d = tid & 127, part = tid >> 7; float acc = 0.f;
        for (int key = part; key <= t; key += 4) { const float p = sc[key]; if (p != 0.f) {
            const bf16_t* v = MOBA ? (const bf16_t*)(F.ws + WS_MQKV) + (size_t)(b * SEQ + key) * NMOBA + 2048 + h * 128 : (const bf16_t*)(F.ws + WS_KV) + (size_t)(b * SEQ + key) * NKV + h * 256 + 128;
            acc += p * bf2f(v[d]); } }
        red[tid] = acc; __syncthreads();
        if (tid < 128) { const float o = (red[tid] + red[tid + 128] + red[tid + 256] + red[tid + 384]) / ltot; misc[40] = 0.f; red[tid] = o; }
        __syncthreads();
        if (tid < 128) { float mo = 0.f; for (int j = 0; j < 128; ++j) mo = fmaxf(mo, fabsf(red[j]));
            const float got = bf2f(((const bf16_t*)(F.ws + WS_Y))[(size_t)(b * SEQ + t) * 2 * DM + (MOBA ? DM : 0) + h * 128 + tid]);
            if (!(fabsf(got - red[tid]) <= 0.02f * mo + 1e-3f)) diag_flag(F, MOBA ? 4u : 2u); }
        __syncthreads();
    }
}
#endif

constexpr int N_PHASES = 16;
struct Args { const float* in[17]; float* out; unsigned char* ws; int ph_lo, ph_hi, li, pad; };
__global__ void __launch_bounds__(NWAVES * 64, 2) fwd_kernel(Args args) {
    extern __shared__ __attribute__((aligned(16))) unsigned char lds[];
    Frame F;
    F.lds = (LAS unsigned char*)lds;
    F.MISC = (volatile LAS unsigned*)(F.lds + MISC_OFF);
    F.G = gridDim.x; { const int bx = blockIdx.x; F.vcu = (F.G % 8 == 0) ? (bx % 8) * (F.G / 8) + bx / 8 : bx; }
    F.ws = args.ws; F.ctl = (gu32*)(args.ws + WS_CTL); F.out = args.out;
    for (int u = threadIdx.x; u < (LDS_BYTES - LDSCTL_OFF) / 4; u += NWAVES * 64) ((LAS unsigned*)(F.lds + LDSCTL_OFF))[u] = 0u;
    __syncthreads();
    if (threadIdx.x == 0) {
#pragma unroll
        for (int i = 0; i < 17; ++i) { const unsigned long long v = (unsigned long long)(uintptr_t)args.in[i]; F.MISC[32 + 2 * i] = (unsigned)v; F.MISC[33 + 2 * i] = (unsigned)(v >> 32); } }
    __syncthreads();
    const int lo = args.ph_lo, hi = args.ph_hi;
    const bool multi = (hi - lo) > 1;
    XcdBarrier bar; bar.bar = (unsigned*)(F.ctl + CW_BAR); bar.x = 0; bar.st = nullptr;
    if (multi) bar = xcd_barrier_post((unsigned*)(F.ctl + CW_BAR), F.MISC + 8);
#ifndef PHMASK
#define PHMASK 0xffff
#endif
#define IN(k) (((PHMASK >> (k)) & 1) && lo <= (k) && (k) < hi)
#define SEAM(k) do { if (IN((k) + 1)) xcd_barrier(bar); } while (0)
#ifndef REPMASK
#define REPMASK 0
#endif
#define REPS(k) _Pragma("unroll 1") for (int rep_ = 0; rep_ < (((REPMASK >> (k)) & 1) ? 2 : 1); ++rep_)
#define PH_BEGIN unsigned long long ws__ = (unsigned long long)(uintptr_t)F.ws; asm volatile("" : "+s"(ws__)); unsigned char* ws = (unsigned char*)(GAS unsigned char*)ws__; \
    unsigned long long out__ = (unsigned long long)(uintptr_t)F.out; asm volatile("" : "+s"(out__)); float* outp = (float*)(GAS float*)out__; bf16_t* GATE = (bf16_t*)outp; (void)GATE; (void)ws;

    if (IN(0)) { REPS(0) p0_prologue(F); SEAM(0); }

    if (IN(1)) { PH_BEGIN
        pg8::Gemm g{(const bf16_t*)(ws + WS_XN), (const bf16_t*)(ws + WS_WIN), M, NIN, DM, DM, 0}; pg8::StaticOrder S; S.init(M, NIN, F.G, (int)blockIdx.x);
        pg8::EpiBf16R E{(bf16_t*)(ws + WS_LAT), NLAT, 3, (bf16_t*)(ws + WS_MQKV), NMOBA, 15, GATE, NGATE};
        REPS(1) pg8::gemm_phase(F.lds, g, S, E);
        SEAM(1);
    }
    if (IN(2)) { p1e_phase(F);
#if DIAG
        xcd_barrier(bar); diag_rope_kmean(F);
#endif
        SEAM(2); }

    if (IN(3)) { PH_BEGIN
        REPS(3) for (int it = F.vcu; it < 256; it += F.G) {
            const int bh = it >> 4, s = it & 15, b = bh >> 3, h = bh & 7;
            att::Head T;
            const bf16_t* base = (const bf16_t*)(ws + WS_MQKV) + (size_t)b * SEQ * NMOBA + h * 128;
            T.Q = base; T.K = base + 1024; T.KR = nullptr; T.V = base + 2048;
            T.O = (bf16_t*)(ws + WS_Y) + (size_t)b * SEQ * 2 * DM + DM + h * 128; T.cosT = nullptr; T.sinT = nullptr;
            T.KM = (const bf16_t*)(ws + WS_KM) + (size_t)bh * 32 * 128;
#pragma unroll 1
#if MOBA_DENSE
            for (int pass = 0; pass < 2; ++pass) att::attn_block<true>(T, pass ? s : 31 - s, (char*)lds);
#else
            for (int pass = 0; pass < 2; ++pass) att::moba_block(T, pass ? s : 31 - s, (char*)lds);
#endif
        }
#if DIAG
        xcd_barrier(bar); diag_attn<true>(F);
#endif
        SEAM(3);
    }
    if (IN(4)) { PH_BEGIN
        { pg8::Gemm g{(const bf16_t*)(ws + WS_LAT), (const bf16_t*)(ws + WS_WUQ), M, NQ, QL, NLAT, 0}; pg8::StaticOrder S; S.init(M, NQ, F.G, (int)blockIdx.x);
          pg8::EpiBf16R E{(bf16_t*)(ws + WS_Q), NQ, 1 << 20, nullptr, 0, 1 << 20, nullptr, 0};
          pg8::gemm_phase(F.lds, g, S, E); }
        { pg8::Gemm g{(const bf16_t*)(ws + WS_LAT) + QL, (const bf16_t*)(ws + WS_WUKV), M, NKV, KVL, NLAT, 0}; pg8::StaticOrder S; S.init(M, NKV, F.G, (int)blockIdx.x);
          pg8::EpiBf16R E{(bf16_t*)(ws + WS_KV), NKV, 1 << 20, nullptr, 0, 1 << 20, nullptr, 0};
          pg8::gemm_phase(F.lds, g, S, E); }
        SEAM(4);
    }
    if (IN(5)) { PH_BEGIN
        REPS(5) for (int it = F.vcu; it < 256; it += F.G) {
            const int bh = it >> 4, s = it & 15, b = bh >> 3, h = bh & 7;
            att::Head T;
            T.Q = (const bf16_t*)(ws + WS_Q) + (size_t)b * SEQ * NQ + h * 192;
            T.K = (const bf16_t*)(ws + WS_KV) + (size_t)b * SEQ * NKV + h * 256;
            T.KR = (const bf16_t*)(ws + WS_LAT) + (size_t)b * SEQ * NLAT + QL + KVL;
            T.V = T.K + 128;
            T.O = (bf16_t*)(ws + WS_Y) + (size_t)b * SEQ * 2 * DM + h * 128;
            T.cosT = (const float*)(ws + WS_CSA); T.sinT = T.cosT + (size_t)SEQ * 32; T.KM = nullptr;
#pragma unroll 1
            for (int pass = 0; pass < 2; ++pass) att::attn_block<false>(T, pass ? s : 31 - s, (char*)lds);
        }
#if DIAG
        xcd_barrier(bar); diag_attn<false>(F);
#endif
        SEAM(5);
    }
    if (IN(6)) { PH_BEGIN
        pg8::Gemm g{(const bf16_t*)(ws + WS_Y), (const bf16_t*)(ws + WS_WOA), M, DM, 2 * DM, 2 * DM, 0}; pg8::StaticOrder S; S.init(M, DM, F.G, (int)blockIdx.x);
        pg8::EpiGate2 E{(bf16_t*)(ws + WS_Z), GATE, ldp(F, 3)};
        REPS(6) pg8::gemm_phase(F.lds, g, S, E);
        SEAM(7);
    }
    if (IN(8)) { PH_BEGIN
        pg8::Gemm g{(const bf16_t*)(ws + WS_Z), (const bf16_t*)(ws + WS_WOUT), M, DM, DM, DM, 0}; pg8::StaticOrder S; S.init(M, DM, F.G, (int)blockIdx.x);
        pg8::EpiResNorm E{ldp(F, 0), outp, (bf16_t*)(ws + WS_XN2), ldp(F, 11), (float*)(ws + WS_SS)};
        REPS(8) pg8::gemm_phase(F.lds, g, S, E);
        SEAM(9);
    }
    if (IN(10)) { PH_BEGIN
        pg8::Gemm g{(const bf16_t*)(ws + WS_XN2), (const bf16_t*)(ws + WS_WUP), 2 * pg8::HP * 256, NUP, DM, DM, 1}; pg8::StaticOrder S; S.init(2 * pg8::HP * 256, NUP, F.G, (int)blockIdx.x);
        pg8::EpiConv E{(bf16_t*)(ws + WS_ACT), (const float*)(ws + WS_SS), ldp(F, 13), ldp(F, 14), F.lds + RING_BYTES};
        REPS(10) pg8::gemm_phase(F.lds, g, S, E);
        SEAM(13);
    }
    if (IN(14)) { PH_BEGIN
        pg8::Gemm g{(const bf16_t*)(ws + WS_ACT), (const bf16_t*)(ws + WS_WDN), M, DM, DFF, DFF, 0}; pg8::StaticOrder S; S.init(M, DM, F.G, (int)blockIdx.x);
        pg8::EpiResF32 E{outp, outp};
        pg8::gemm_phase(F.lds, g, S, E);
        SEAM(14);
    }
    if (IN(15)) { PH_BEGIN
        const int tid = tid_(), lane = tid & 63, wave = __builtin_amdgcn_readfirstlane(tid >> 6);
        const int gw = F.vcu * NWAVES + wave, NGW = F.G * NWAVES; const float* g_ = ldp(F, 16);
        for (int m = gw; m < M; m += NGW) rms_row_f32(lane, outp + (size_t)m * DM, g_, outp + (size_t)m * DM);
#if DIAG
        xcd_barrier(bar);
        if (blockIdx.x == 0 && threadIdx.x == 0) { const unsigned code = __hip_atomic_load((unsigned*)(F.ctl + CW_DIAG), RLX_AGENT); if (code) outp[0] = 1000.f * (float)code; }
#endif
    }
#undef IN
#undef SEAM
}

extern "C" void kernel_launch(void* const* d_in, const int* in_sizes, int n_in, void* d_out, int out_size, void* d_ws, size_t ws_size, hipStream_t stream) {
    static int grid = 0;
    if (grid == 0) {
        if (n_in != 17 || in_sizes[0] != M * DM || out_size != M * DM || ws_size < WS_END) {
            fprintf(stderr, "kernel_launch: unexpected shapes: n_in %d in0 %d out %d ws %zu; nothing launched\n", n_in, n_in > 0 ? in_sizes[0] : -1, out_size, ws_size); grid = -1; return; }
        int dev = 0, cus = 0;
        if (hipGetDevice(&dev) != hipSuccess || hipDeviceGetAttribute(&cus, hipDeviceAttributeMultiprocessorCount, dev) != hipSuccess) { grid = -1; return; }
        if (hipFuncSetAttribute((const void*)fwd_kernel, hipFuncAttributeMaxDynamicSharedMemorySize, LDS_BYTES) != hipSuccess) { fprintf(stderr, "kernel_launch: hipFuncSetAttribute failed\n"); grid = -1; return; }
        int per_cu = 0;
        if (hipOccupancyMaxActiveBlocksPerMultiprocessor(&per_cu, (const void*)fwd_kernel, NWAVES * 64, LDS_BYTES) != hipSuccess || per_cu < 1)
            fprintf(stderr, "kernel_launch: note: occupancy query reports %d workgroups per CU\n", per_cu);
        (void)hipGetLastError();
        grid = cus;
    }
    if (grid < 0) return;
    if (hipMemsetAsync((char*)d_ws + WS_CTL, 0, CTL_ZERO_BYTES, stream) != hipSuccess) { fprintf(stderr, "kernel_launch: memset failed\n"); return; }
    Args a{};
    for (int i = 0; i < 17; ++i) a.in[i] = (const float*)d_in[i];
    a.out = (float*)d_out; a.ws = (unsigned char*)d_ws;
#if MK_N_LAUNCHES == 1
    a.ph_lo = 0; a.ph_hi = N_PHASES; a.li = 0;
    hipLaunchKernelGGL(fwd_kernel, dim3(grid), dim3(NWAVES * 64), LDS_BYTES, stream, a);
#else
    for (int li = 0; li < N_PHASES; ++li) { a.ph_lo = li; a.ph_hi = li + 1; a.li = li;
        hipLaunchKernelGGL(fwd_kernel, dim3(grid), dim3(NWAVES * 64), LDS_BYTES, stream, a); }
#endif
}
```
